# Optimizing an MI355X kernel written in HIP

```python
import math
import jax
import jax.numpy as jnp
from jax import lax
import numpy as np


D_MODEL = 1024
BATCH = 2
SEQ = 8192
DEPTH = 2

N_BRANCH = 4
SC_WIDTH = D_MODEL // 4
SC_GROUPS = 4
SC_K = 3
LRU_WIDTH = D_MODEL // 4
LRU_HEADS = 4
LRU_HEAD_DIM = LRU_WIDTH // LRU_HEADS
LRU_CONV_K = 4
LRU_C = 8.0
SG_WIDTH = D_MODEL // 4
SG_GROUPS = 4
SG_GROUP_DIM = SG_WIDTH // SG_GROUPS
SG_CHUNK = 128
RET_WIDTH = D_MODEL // 4
RET_HEADS = 4
RET_HEAD_DIM = RET_WIDTH // RET_HEADS
RET_CHUNK = 128
ROPE_BASE = 10000.0
N_GROUPS = 4
EXPERTS_PER_GROUP = 8
N_EXPERTS = N_GROUPS * EXPERTS_PER_GROUP
TOP_K = 2
D_EXPERT = D_MODEL // 4
LN_EPS = 1e-5
DEEPNORM_ALPHA = (2.0 * DEPTH) ** 0.25
DEEPNORM_BETA = (8.0 * DEPTH) ** -0.25

kernel_name = 'hybrid_gated_parallel_mixers_hier_moe_deepnorm'


def _standardize(x):
    x32 = x.astype(jnp.float32)
    mu = jnp.mean(x32, axis=-1, keepdims=True)
    var = jnp.mean(jnp.square(x32 - mu), axis=-1, keepdims=True)
    return (x32 - mu) * lax.rsqrt(var + LN_EPS)


def _layer_norm(x, g, b):
    return (_standardize(x) * g.astype(jnp.float32) + b.astype(jnp.float32)).astype(x.dtype)


def _causal_depthwise_conv(x, w, b):
    k = w.shape[0]
    c = x.shape[-1]
    y = lax.conv_general_dilated(x, w[:, None, :].astype(x.dtype), window_strides=(1,),
                                 padding=[(k - 1, 0)], dimension_numbers=('NWC', 'WIO', 'NWC'),
                                 feature_group_count=c)
    return y + b.astype(x.dtype)


def _rope_tables(positions):
    half = RET_HEAD_DIM // 2
    inv_freq = ROPE_BASE ** (-jnp.arange(half, dtype=jnp.float32) / half)
    ang = positions.astype(jnp.float32)[..., None] * inv_freq
    return jnp.cos(ang)[:, :, None, :], jnp.sin(ang)[:, :, None, :]


def _apply_rope(t, cos, sin):
    t1, t2 = jnp.split(t.astype(jnp.float32), 2, axis=-1)
    return jnp.concatenate([t1 * cos - t2 * sin, t2 * cos + t1 * sin], axis=-1)


def _short_conv_mixer(b_gate, c_gate, xa, conv_w, conv_b):
    return b_gate * _causal_depthwise_conv(c_gate * xa, conv_w, conv_b)


def _rg_lru_mixer(xb, conv_w, conv_b, w_r, b_r, w_i, b_i, lam):
    bsz, seq, width = xb.shape
    xc = _causal_depthwise_conv(xb, conv_w, conv_b)
    xh = xc.reshape(bsz, seq, LRU_HEADS, LRU_HEAD_DIM)
    r = jax.nn.sigmoid(jnp.einsum('bshd,hde->bshe', xh, w_r).reshape(bsz, seq, width) + b_r).astype(jnp.float32)
    i = jax.nn.sigmoid(jnp.einsum('bshd,hde->bshe', xh, w_i).reshape(bsz, seq, width) + b_i).astype(jnp.float32)
    log_a = -LRU_C * r * jax.nn.softplus(-lam.astype(jnp.float32))
    a = jnp.exp(log_a)
    u = jnp.sqrt(-jnp.expm1(2.0 * log_a)) * (i * xc.astype(jnp.float32))

    def combine(left, right):
        a_l, h_l = left
        a_r, h_r = right
        return a_l * a_r, a_r * h_l + h_r

    _, h = lax.associative_scan(combine, (a, u), axis=1)
    return h.astype(xb.dtype)


def _chunked_spatial_gating(zu, zv, norm_g, w_s, b_s):
    bsz, seq, width = zu.shape
    n_chunks = seq // SG_CHUNK
    u = jax.nn.gelu(zu)
    v = jax.nn.gelu(zv).reshape(bsz, seq, SG_GROUPS, SG_GROUP_DIM)
    v = _standardize(v) * norm_g.astype(jnp.float32).reshape(SG_GROUPS, SG_GROUP_DIM)
    v = v.reshape(bsz, n_chunks, SG_CHUNK, SG_GROUPS, SG_GROUP_DIM)
    causal = jnp.tril(jnp.ones((SG_CHUNK, SG_CHUNK), jnp.float32))
    sv = jnp.einsum('gts,bcsgd->bctgd', w_s.astype(jnp.float32) * causal, v) \
        + b_s.astype(jnp.float32).T[:, :, None]
    return u * sv.reshape(bsz, seq, width).astype(zu.dtype)


def _retention(zq, zk, zv, zg, norm_g, cos, sin):
    bsz, seq, width = zq.shape
    n_chunks = seq // RET_CHUNK
    shp = (bsz, seq, RET_HEADS, RET_HEAD_DIM)
    cshp = (bsz, n_chunks, RET_CHUNK, RET_HEADS, RET_HEAD_DIM)
    q = _apply_rope(zq.reshape(shp), cos, sin).reshape(cshp)
    k = (_apply_rope(zk.reshape(shp), cos, sin) * RET_HEAD_DIM ** -0.5).reshape(cshp)
    v = zv.astype(jnp.float32).reshape(cshp)
    log_gamma = jnp.log1p(-jnp.exp2(-5.0 - jnp.arange(RET_HEADS, dtype=jnp.float32)))
    pos = jnp.arange(RET_CHUNK, dtype=jnp.float32)
    diff = pos[:, None] - pos[None, :]
    decay = jnp.where(diff >= 0, jnp.exp(jnp.maximum(diff, 0.0) * log_gamma[:, None, None]), 0.0)
    scores = jnp.einsum('bcnhd,bcmhd->bchnm', q, k) * decay
    inner = jnp.einsum('bchnm,bcmhe->bcnhe', scores, v)
    k_decay = jnp.exp((RET_CHUNK - 1.0 - pos)[:, None] * log_gamma)
    kv = jnp.einsum('bcmhd,bcmhe,mh->bchde', k, v, k_decay)
    chunk_decay = jnp.exp(RET_CHUNK * log_gamma)[None, :, None, None]

    def step(state, kv_c):
        return chunk_decay * state + kv_c, state

    init = jnp.zeros((bsz, RET_HEADS, RET_HEAD_DIM, RET_HEAD_DIM), jnp.float32)
    _, prev = lax.scan(step, init, jnp.moveaxis(kv, 1, 0))
    prev = jnp.moveaxis(prev, 0, 1)
    q_decay = jnp.exp((pos + 1.0)[:, None] * log_gamma)
    cross = jnp.einsum('bcnhd,bchde,nh->bcnhe', q, prev, q_decay)
    o = (inner + cross).reshape(shp)
    o = (_standardize(o) * norm_g.astype(jnp.float32).reshape(RET_HEADS, RET_HEAD_DIM)).reshape(bsz, seq, width)
    return (jax.nn.silu(zg.astype(jnp.float32)) * o).astype(zq.dtype)


def _hier_moe(h, wg, bg, we, be, w_gate, w_up, w_down):
    bsz, seq, d = h.shape
    ht = h.reshape(-1, d)
    g_prob = jax.nn.softmax((ht @ wg + bg).astype(jnp.float32), axis=-1)
    g_top_p, g_idx = lax.top_k(g_prob, 1)
    e_logits = (ht @ we + be).astype(jnp.float32).reshape(-1, N_GROUPS, EXPERTS_PER_GROUP)
    sel = jnp.take_along_axis(e_logits, g_idx[:, :, None], axis=1)[:, 0]
    e_prob = jax.nn.softmax(sel, axis=-1)
    top_p, top_i = lax.top_k(e_prob, TOP_K)
    top_p = top_p / jnp.sum(top_p, axis=-1, keepdims=True)
    weights = g_top_p * top_p
    expert_id = g_idx * EXPERTS_PER_GROUP + top_i
    combine = jnp.sum(jax.nn.one_hot(expert_id, N_EXPERTS, dtype=jnp.float32) * weights[..., None], axis=1)
    out = jnp.zeros(ht.shape, jnp.float32)
    for e in range(N_EXPERTS):
        hid = jax.nn.silu(ht @ w_gate[e]) * (ht @ w_up[e])
        out = out + combine[:, e:e + 1] * (hid @ w_down[e]).astype(jnp.float32)
    return out.reshape(bsz, seq, d).astype(h.dtype)


def setup_inputs(seed: int = 0) -> dict:
    key = jax.random.key(seed)
    k = jax.random.split(key, 32)
    L, D = DEPTH, D_MODEL
    f32 = jnp.float32

    def nrm(i, shape, scale):
        return jax.random.normal(k[i], shape, f32) * scale

    n_in = 3 * SC_WIDTH + LRU_WIDTH + 2 * SG_WIDTH + 4 * RET_WIDTH + N_BRANCH * D
    u = jax.random.uniform(k[10], (L, LRU_WIDTH), f32, 0.9, 0.999)
    a0 = u ** (1.0 / LRU_C)
    return {
        'x': nrm(0, (BATCH, SEQ, D), 1.0),
        'positions': jnp.broadcast_to(jnp.arange(SEQ, dtype=jnp.int32)[None, :], (BATCH, SEQ)),
        'w_in': nrm(1, (L, D, n_in), D ** -0.5),
        'sc_conv_w': nrm(2, (L, SC_K, SC_WIDTH), SC_K ** -0.5),
        'sc_conv_b': nrm(3, (L, SC_WIDTH), 0.01),
        'lru_conv_w': nrm(4, (L, LRU_CONV_K, LRU_WIDTH), LRU_CONV_K ** -0.5),
        'lru_conv_b': nrm(5, (L, LRU_WIDTH), 0.01),
        'lru_w_r': nrm(6, (L, LRU_HEADS, LRU_HEAD_DIM, LRU_HEAD_DIM), LRU_HEAD_DIM ** -0.5),
        'lru_b_r': nrm(7, (L, LRU_WIDTH), 0.01),
        'lru_w_i': nrm(8, (L, LRU_HEADS, LRU_HEAD_DIM, LRU_HEAD_DIM), LRU_HEAD_DIM ** -0.5),
        'lru_b_i': nrm(9, (L, LRU_WIDTH), 0.01),
        'lru_lambda': jnp.log(a0) - jnp.log1p(-a0),
        'sg_norm_g': 1.0 + nrm(11, (L, SG_WIDTH), 0.02),
        'sg_w_s': nrm(12, (L, SG_GROUPS, SG_CHUNK, SG_CHUNK), SG_CHUNK ** -0.5),
        'sg_b_s': 1.0 + nrm(13, (L, SG_GROUPS, SG_CHUNK), 0.02),
        'ret_norm_g': 1.0 + nrm(14, (L, RET_WIDTH), 0.02),
        'branch_proj': nrm(15, (L, N_BRANCH, SC_WIDTH, D), SC_WIDTH ** -0.5 * DEEPNORM_BETA),
        'w_out': nrm(16, (L, D, D), D ** -0.5 * DEEPNORM_BETA),
        'ln_mix_g': 1.0 + nrm(17, (L, D), 0.02),
        'ln_mix_b': nrm(18, (L, D), 0.02),
        'router_group_w': nrm(19, (L, D, N_GROUPS), D ** -0.5),
        'router_group_b': nrm(20, (L, N_GROUPS), 0.01),
        'router_expert_w': nrm(21, (L, D, N_EXPERTS), D ** -0.5),
        'router_expert_b': nrm(22, (L, N_EXPERTS), 0.01),
        'exp_w_gate': nrm(23, (L, N_EXPERTS, D, D_EXPERT), D ** -0.5),
        'exp_w_up': nrm(24, (L, N_EXPERTS, D, D_EXPERT), D ** -0.5),
        'exp_w_down': nrm(25, (L, N_EXPERTS, D_EXPERT, D), D_EXPERT ** -0.5 * DEEPNORM_BETA),
        'ln_ffn_g': 1.0 + nrm(26, (L, D), 0.02),
        'ln_ffn_b': nrm(27, (L, D), 0.02),
    }


def reference(x, positions, w_in, sc_conv_w, sc_conv_b, lru_conv_w, lru_conv_b, lru_w_r, lru_b_r,
              lru_w_i, lru_b_i, lru_lambda, sg_norm_g, sg_w_s, sg_b_s, ret_norm_g, branch_proj, w_out,
              ln_mix_g, ln_mix_b, router_group_w, router_group_b, router_expert_w, router_expert_b,
              exp_w_gate, exp_w_up, exp_w_down, ln_ffn_g, ln_ffn_b):
    dt = x.dtype
    cos, sin = _rope_tables(positions)
    widths = [SC_WIDTH] * 3 + [LRU_WIDTH] + [SG_WIDTH] * 2 + [RET_WIDTH] * 4 + [D_MODEL] * N_BRANCH
    split_at = [int(s) for s in np.cumsum(widths)[:-1]]
    h = x
    for l in range(DEPTH):
        z = h @ w_in[l]
        (sc_b, sc_c, sc_x, lru_x, sg_u, sg_v, r_q, r_k, r_v, r_g, *gate_logits) = jnp.split(z, split_at, axis=-1)
        branches = (
            _short_conv_mixer(sc_b, sc_c, sc_x, sc_conv_w[l], sc_conv_b[l]),
            _rg_lru_mixer(lru_x, lru_conv_w[l], lru_conv_b[l], lru_w_r[l], lru_b_r[l],
                          lru_w_i[l], lru_b_i[l], lru_lambda[l]),
            _chunked_spatial_gating(sg_u, sg_v, sg_norm_g[l], sg_w_s[l], sg_b_s[l]),
            _retention(r_q, r_k, r_v, r_g, ret_norm_g[l], cos, sin),
        )
        merged = jnp.zeros(h.shape, dt)
        for b_idx in range(N_BRANCH):
            merged = merged + (jax.nn.sigmoid(gate_logits[b_idx]) * (branches[b_idx] @ branch_proj[l, b_idx])).astype(dt)
        mix = (merged @ w_out[l]).astype(dt)
        h = _layer_norm(DEEPNORM_ALPHA * h + mix, ln_mix_g[l], ln_mix_b[l])
        ffn = _hier_moe(h, router_group_w[l], router_group_b[l], router_expert_w[l], router_expert_b[l],
                        exp_w_gate[l], exp_w_up[l], exp_w_down[l])
        h = _layer_norm(DEEPNORM_ALPHA * h + ffn, ln_ffn_g[l], ln_ffn_b[l])
    return h
```

```cpp
#ifndef HOST_EMU
#include <hip/hip_runtime.h>
#include <hip/hip_cooperative_groups.h>
#include <cstdio>
#include <cstdint>
#include <cstring>
#define DEV __device__ __forceinline__
#else
#include <cmath>
#include <cstdio>
#include <cstdint>
#include <cstring>
#define DEV inline
#endif

typedef unsigned short bf16_t;
struct __attribute__((aligned(16))) u4 { unsigned x, y, z, w; };
#ifndef SEQ
#define SEQ 8192
#endif
constexpr int NB = 2, S = SEQ, T = NB * S, D = 1024, NIN = 6656, NMIX = 2560, NGATE = 4096, NCH = S / 128, NCHT = T / 128;
constexpr int NE = 32, SLOTCAP = 2 * T + NE * 256;
constexpr int C_SCB = 0, C_SCC = 256, C_SCX = 512, C_LRX = 768, C_SGU = 1024, C_SGV = 1280, C_RQ = 1536, C_RK = 1792, C_RV = 2048, C_RG = 2304;
constexpr float ALPHA = 1.4142135623730951f, LN_EPS = 1e-5f;

struct Ctx {
    const float* x; const int* pos; const float* w_in; const float* sc_w; const float* sc_b; const float* lru_cw; const float* lru_cb;
    const float* lru_wr; const float* lru_br; const float* lru_wi; const float* lru_bi; const float* lru_lam; const float* sg_ng; const float* sg_ws; const float* sg_bs;
    const float* ret_ng; const float* bproj; const float* wout; const float* ln1g; const float* ln1b; const float* rgw; const float* rgb; const float* rew; const float* reb;
    const float* ewg; const float* ewu; const float* ewd; const float* ln2g; const float* ln2b;
    float* out;
    unsigned* ctl; bf16_t* w_in_t; bf16_t* bp_t; bf16_t* wout_t; float* ropec; float* ropes; float* rstate; float* lruA; float* lruH; float* lruC; float* sgstat;
    int* tok_e; int* tok_pos; float* tok_w; int* tok_slot;
    bf16_t* bufA; bf16_t* bufB; bf16_t* zmix; bf16_t* zgate; float* part; bf16_t* expA; bf16_t* expB; bf16_t* xg; bf16_t* hid;
};

constexpr size_t MiB = 1u << 20;
constexpr size_t cmax(size_t a, size_t b) { return a > b ? a : b; }
constexpr size_t WS_CTL = 0, CTL_BYTES = 1 * MiB;
constexpr size_t WS_WIN = WS_CTL + CTL_BYTES;
constexpr size_t WS_BP = WS_WIN + (size_t)2 * NIN * D * 2;
constexpr size_t WS_WOUT = WS_BP + (size_t)2 * 4 * D * 256 * 2;
constexpr size_t WS_ROPEC = WS_WOUT + (size_t)2 * D * D * 2;
constexpr size_t WS_ROPES = WS_ROPEC + (size_t)T * 32 * 4;
constexpr size_t WS_RSTATE = WS_ROPES + (size_t)T * 32 * 4;
constexpr size_t WS_LRUA = WS_RSTATE + (size_t)NB * NCH * 4 * 4096 * 4;
constexpr size_t WS_LRUH = WS_LRUA + (size_t)NCHT * 256 * 4;
constexpr size_t WS_LRUC = WS_LRUH + (size_t)NCHT * 256 * 4;
constexpr size_t WS_SGST = WS_LRUC + (size_t)NCHT * 256 * 4;
constexpr size_t WS_TOKE = WS_SGST + (size_t)T * 4 * 2 * 4;
constexpr size_t WS_TOKP = WS_TOKE + (size_t)T * 2 * 4;
constexpr size_t WS_TOKW = WS_TOKP + (size_t)T * 2 * 4;
constexpr size_t WS_TOKS = WS_TOKW + (size_t)T * 2 * 4;
constexpr size_t WS_BUFA = WS_TOKS + (size_t)T * 2 * 4;
constexpr size_t WS_BUFB = WS_BUFA + (size_t)T * D * 2;
constexpr size_t WS_ZR = WS_BUFB + (size_t)T * D * 2;
constexpr size_t ZR_ZGATE = (size_t)T * NMIX * 2;
constexpr size_t ZR_EXPB = (size_t)NE * 512 * D * 2;
constexpr size_t ZR_XG = ZR_EXPB + (size_t)NE * D * 256 * 2;
constexpr size_t ZR_HID = ZR_XG + (size_t)SLOTCAP * D * 2;
constexpr size_t ZR_BYTES = cmax((size_t)T * NIN * 2, ZR_HID + (size_t)SLOTCAP * 256 * 2);
constexpr size_t WS_END = WS_ZR + ZR_BYTES;
constexpr int CW_CNT = 1024;

inline void ctx_fill(Ctx& c, void* const* d_in, void* d_out, void* d_ws) {
    const float* const* f = (const float* const*)d_in;
    c.x = f[0]; c.pos = (const int*)d_in[1]; c.w_in = f[2]; c.sc_w = f[3]; c.sc_b = f[4]; c.lru_cw = f[5]; c.lru_cb = f[6]; c.lru_wr = f[7]; c.lru_br = f[8]; c.lru_wi = f[9];
    c.lru_bi = f[10]; c.lru_lam = f[11]; c.sg_ng = f[12]; c.sg_ws = f[13]; c.sg_bs = f[14]; c.ret_ng = f[15]; c.bproj = f[16]; c.wout = f[17]; c.ln1g = f[18]; c.ln1b = f[19];
    c.rgw = f[20]; c.rgb = f[21]; c.rew = f[22]; c.reb = f[23]; c.ewg = f[24]; c.ewu = f[25]; c.ewd = f[26]; c.ln2g = f[27]; c.ln2b = f[28];
    c.out = (float*)d_out;
    unsigned char* w = (unsigned char*)d_ws;
    c.ctl = (unsigned*)(w + WS_CTL); c.w_in_t = (bf16_t*)(w + WS_WIN); c.bp_t = (bf16_t*)(w + WS_BP); c.wout_t = (bf16_t*)(w + WS_WOUT);
    c.ropec = (float*)(w + WS_ROPEC); c.ropes = (float*)(w + WS_ROPES); c.rstate = (float*)(w + WS_RSTATE); c.lruA = (float*)(w + WS_LRUA); c.lruH = (float*)(w + WS_LRUH);
    c.lruC = (float*)(w + WS_LRUC); c.sgstat = (float*)(w + WS_SGST); c.tok_e = (int*)(w + WS_TOKE); c.tok_pos = (int*)(w + WS_TOKP); c.tok_w = (float*)(w + WS_TOKW);
    c.tok_slot = (int*)(w + WS_TOKS); c.bufA = (bf16_t*)(w + WS_BUFA); c.bufB = (bf16_t*)(w + WS_BUFB);
    c.zmix = (bf16_t*)(w + WS_ZR); c.zgate = (bf16_t*)(w + WS_ZR + ZR_ZGATE); c.part = (float*)(w + WS_ZR);
    c.expA = (bf16_t*)(w + WS_ZR); c.expB = (bf16_t*)(w + WS_ZR + ZR_EXPB); c.xg = (bf16_t*)(w + WS_ZR + ZR_XG); c.hid = (bf16_t*)(w + WS_ZR + ZR_HID);
}

DEV float bf2f(bf16_t v) { unsigned u = (unsigned)v << 16; float f; memcpy(&f, &u, 4); return f; }
DEV bf16_t f2bf(float f) { unsigned u; memcpy(&u, &f, 4); return (bf16_t)((u + 0x7fffu + ((u >> 16) & 1u)) >> 16); }
DEV float sigm(float x) { return 1.f / (1.f + expf(-x)); }
DEV float silu_(float x) { return x * sigm(x); }
DEV float gelu_(float x) { return 0.5f * x * (1.f + tanhf(0.7978845608028654f * (x + 0.044715f * x * x * x))); }
DEV float softplus_(float x) { return x > 20.f ? x : log1pf(expf(x)); }
DEV float ret_lg(int hd) { return log1pf(-exp2f(-5.f - (float)hd)); }
DEV unsigned atom_add(unsigned* p, unsigned v) {
#ifndef HOST_EMU
    return atomicAdd(p, v);
#else
    return __atomic_fetch_add(p, v, __ATOMIC_RELAXED);
#endif
}

DEV void conv_wT(const float* W, int K, int N, bf16_t* WT, int gtid, int gsz) {
    const size_t n_el = (size_t)K * N;
    for (size_t i = gtid; i < n_el; i += gsz) { const int n = (int)(i / K), k = (int)(i % K); WT[i] = f2bf(W[(size_t)k * N + n]); }
}
DEV void p0_prologue(const Ctx& c, int gtid, int gsz) {
    for (int l = 0; l < 2; ++l) {
        conv_wT(c.w_in + (size_t)l * D * NIN, D, NIN, c.w_in_t + (size_t)l * NIN * D, gtid, gsz);
        for (int b = 0; b < 4; ++b) conv_wT(c.bproj + ((size_t)l * 4 + b) * 256 * D, 256, D, c.bp_t + ((size_t)l * 4 + b) * D * 256, gtid, gsz);
        conv_wT(c.wout + (size_t)l * D * D, D, D, c.wout_t + (size_t)l * D * D, gtid, gsz);
    }
    for (int i = gtid; i < T * 32; i += gsz) {
        const int t = i >> 5, j = i & 31;
        const float inv = exp2f(-(float)j * (13.287712379549449f / 32.f));
        const float ang = (float)c.pos[t] * inv;
        c.ropec[i] = cosf(ang); c.ropes[i] = sinf(ang);
    }
    for (size_t i = gtid; i < (size_t)T * D; i += gsz) { const float v = c.x[i]; c.out[i] = v; c.bufA[i] = f2bf(v); }
}

DEV void p2_rope_stats(const Ctx& c, int gtid, int gsz) {
    for (int i = gtid; i < T * 4 * 32; i += gsz) {
        const int t = i >> 7, hd = (i >> 5) & 3, j = i & 31;
        const float cs = c.ropec[t * 32 + j], sn = c.ropes[t * 32 + j];
        bf16_t* q = c.zmix + (size_t)t * NMIX + C_RQ + hd * 64 + j; bf16_t* k = c.zmix + (size_t)t * NMIX + C_RK + hd * 64 + j;
        const float q1 = bf2f(q[0]), q2 = bf2f(q[32]), k1 = bf2f(k[0]), k2 = bf2f(k[32]);
        q[0] = f2bf(q1 * cs - q2 * sn); q[32] = f2bf(q2 * cs + q1 * sn);
        k[0] = f2bf((k1 * cs - k2 * sn) * 0.125f); k[32] = f2bf((k2 * cs + k1 * sn) * 0.125f);
    }
    for (int i = gtid; i < T * 4; i += gsz) {
        const int t = i >> 2, g = i & 3; const bf16_t* zv = c.zmix + (size_t)t * NMIX + C_SGV + g * 64;
        float s = 0.f; for (int d = 0; d < 64; ++d) s += gelu_(bf2f(zv[d]));
        const float mu = s * (1.f / 64.f); float q = 0.f;
        for (int d = 0; d < 64; ++d) { const float v = gelu_(bf2f(zv[d])) - mu; q += v * v; }
        c.sgstat[i * 2] = mu; c.sgstat[i * 2 + 1] = 1.f / sqrtf(q * (1.f / 64.f) + LN_EPS);
    }
}

DEV void lru_au(const Ctx& c, int l, int t, int ch, float& a, float& u) {
    const int hd = ch >> 6, e = ch & 63, s = t % S;
    const float* cw = c.lru_cw + l * 4 * 256; const float* cb = c.lru_cb + l * 256;
    const float* wr = c.lru_wr + (size_t)(l * 4 + hd) * 4096; const float* wi = c.lru_wi + (size_t)(l * 4 + hd) * 4096;
    float rp = c.lru_br[l * 256 + ch], ip = c.lru_bi[l * 256 + ch], xce = 0.f;
    for (int d = 0; d < 64; ++d) {
        const int cc = hd * 64 + d; float xc = cb[cc];
        for (int j = 0; j < 4; ++j) { const int sj = s - 3 + j; if (sj >= 0) xc += cw[j * 256 + cc] * bf2f(c.zmix[(size_t)(t - 3 + j) * NMIX + C_LRX + cc]); }
        rp += xc * wr[d * 64 + e]; ip += xc * wi[d * 64 + e];
        if (d == e) xce = xc;
    }
    const float r = sigm(rp), ig = sigm(ip);
    const float la = -8.f * r * softplus_(-c.lru_lam[l * 256 + ch]);
    a = expf(la); u = sqrtf(-expm1f(2.f * la)) * (ig * xce);
}

DEV void p2b_chunk_local(const Ctx& c, int l, int gtid, int gsz) {
    for (int i = gtid; i < NCHT * 4 * 4096; i += gsz) {
        const int e = i & 63, d = (i >> 6) & 63, hd = (i >> 12) & 3, gc = i >> 14; const int t0 = gc * 128;
        const float lg = ret_lg(hd); float acc = 0.f;
        for (int m = 0; m < 128; ++m) {
            const bf16_t* row = c.zmix + (size_t)(t0 + m) * NMIX;
            acc += bf2f(row[C_RK + hd * 64 + d]) * bf2f(row[C_RV + hd * 64 + e]) * expf((float)(127 - m) * lg);
        }
        c.rstate[i] = acc;
    }
    for (int i = gtid; i < NCHT * 256; i += gsz) {
        const int ch = i & 255, gc = i >> 8; float A = 1.f, H = 0.f;
        for (int m = 0; m < 128; ++m) { float a, u; lru_au(c, l, gc * 128 + m, ch, a, u); H = a * H + u; A *= a; }
        c.lruA[i] = A; c.lruH[i] = H;
    }
}

DEV void p3_scan(const Ctx& c, int gtid, int gsz) {
    for (int i = gtid; i < NB * 4 * 4096; i += gsz) {
        const int de = i & 4095, hd = (i >> 12) & 3, b = i >> 14;
        const float cd = expf(128.f * ret_lg(hd)); float st = 0.f;
        for (int ci = 0; ci < NCH; ++ci) { float* p = c.rstate + ((size_t)((b * NCH + ci) * 4 + hd) * 4096 + de); const float kv = *p; *p = st; st = cd * st + kv; }
    }
    for (int i = gtid; i < NB * 256; i += gsz) {
        const int ch = i & 255, b = i >> 8; float carry = 0.f;
        for (int ci = 0; ci < NCH; ++ci) { const int j = (b * NCH + ci) * 256 + ch; c.lruC[j] = carry; carry = c.lruA[j] * carry + c.lruH[j]; }
    }
}

DEV void p4_mixers(const Ctx& c, int l, int gtid, int gsz) {
    bf16_t* br0 = c.bufB; bf16_t* br1 = c.bufB + (size_t)T * 256; bf16_t* br2 = c.bufB + (size_t)2 * T * 256; bf16_t* br3 = c.bufB + (size_t)3 * T * 256;
    for (int i = gtid; i < T * 256; i += gsz) {
        const int ch = i & 255, t = i >> 8, s = t % S; float acc = c.sc_b[l * 256 + ch];
        for (int j = 0; j < 3; ++j) { const int sj = s - 2 + j; if (sj >= 0) { const bf16_t* row = c.zmix + (size_t)(t - 2 + j) * NMIX; acc += c.sc_w[(l * 3 + j) * 256 + ch] * (bf2f(row[C_SCC + ch]) * bf2f(row[C_SCX + ch])); } }
        br0[i] = f2bf(bf2f(c.zmix[(size_t)t * NMIX + C_SCB + ch]) * acc);
    }
    for (int i = gtid; i < NCHT * 256; i += gsz) {
        const int ch = i & 255, gc = i >> 8; float h = c.lruC[i];
        for (int m = 0; m < 128; ++m) { float a, u; lru_au(c, l, gc * 128 + m, ch, a, u); h = a * h + u; br1[(size_t)(gc * 128 + m) * 256 + ch] = f2bf(h); }
    }
    for (int i = gtid; i < T * 256; i += gsz) {
        const int ch = i & 255, t = i >> 8, g = ch >> 6, tt = t & 127, t0 = t - tt;
        const float* ws = c.sg_ws + ((size_t)(l * 4 + g) * 128 + tt) * 128; const float ng = c.sg_ng[l * 256 + ch];
        float sv = c.sg_bs[(l * 4 + g) * 128 + tt];
        for (int s2 = 0; s2 <= tt; ++s2) {
            const float mu = c.sgstat[((t0 + s2) * 4 + g) * 2], rs = c.sgstat[((t0 + s2) * 4 + g) * 2 + 1];
            sv += ws[s2] * ((gelu_(bf2f(c.zmix[(size_t)(t0 + s2) * NMIX + C_SGV + ch])) - mu) * rs * ng);
        }
        br2[i] = f2bf(gelu_(bf2f(c.zmix[(size_t)t * NMIX + C_SGU + ch])) * sv);
    }
    for (int i = gtid; i < T * 4; i += gsz) {
        const int hd = i & 3, t = i >> 2, n = t & 127, t0 = t - n, gc = t >> 7;
        const float lg = ret_lg(hd);
        float q[64], o[64];
        const bf16_t* qrow = c.zmix + (size_t)t * NMIX + C_RQ + hd * 64;
#pragma unroll
        for (int d = 0; d < 64; ++d) { q[d] = bf2f(qrow[d]); o[d] = 0.f; }
        for (int m = 0; m <= n; ++m) {
            const bf16_t* row = c.zmix + (size_t)(t0 + m) * NMIX; float sc = 0.f;
#pragma unroll
            for (int d = 0; d < 64; ++d) sc += q[d] * bf2f(row[C_RK + hd * 64 + d]);
            sc *= expf((float)(n - m) * lg);
#pragma unroll
            for (int e = 0; e < 64; ++e) o[e] += sc * bf2f(row[C_RV + hd * 64 + e]);
        }
        const float qd = expf((float)(n + 1) * lg); const float* prev = c.rstate + (size_t)(gc * 4 + hd) * 4096;
        for (int d = 0; d < 64; ++d) { const float qq = bf2f(qrow[d]) * qd;
#pragma unroll
            for (int e = 0; e < 64; ++e) o[e] += qq * prev[d * 64 + e]; }
        float s = 0.f;
#pragma unroll
        for (int e = 0; e < 64; ++e) s += o[e];
        const float mu = s * (1.f / 64.f); float v2 = 0.f;
#pragma unroll
        for (int e = 0; e < 64; ++e) { const float dd = o[e] - mu; v2 += dd * dd; }
        const float rs = 1.f / sqrtf(v2 * (1.f / 64.f) + LN_EPS);
#pragma unroll
        for (int e = 0; e < 64; ++e) { const float on = (o[e] - mu) * rs * c.ret_ng[l * 256 + hd * 64 + e];
            br3[(size_t)t * 256 + hd * 64 + e] = f2bf(silu_(bf2f(c.zmix[(size_t)t * NMIX + C_RG + hd * 64 + e])) * on); }
    }
}

DEV void p7_ln_router(const Ctx& c, int l, int gtid, int gsz) {
    for (int t = gtid; t < T; t += gsz) {
        float* row = c.out + (size_t)t * D; float s = 0.f;
        for (int k = 0; k < D; ++k) s += row[k];
        const float mu = s * (1.f / D); float v2 = 0.f;
        for (int k = 0; k < D; ++k) { const float dd = row[k] - mu; v2 += dd * dd; }
        const float rs = 1.f / sqrtf(v2 * (1.f / D) + LN_EPS);
        float lg[36];
#pragma unroll
        for (int j = 0; j < 4; ++j) lg[j] = c.rgb[l * 4 + j];
#pragma unroll
        for (int j = 0; j < 32; ++j) lg[4 + j] = c.reb[l * 32 + j];
        for (int k = 0; k < D; ++k) {
            const float h = (row[k] - mu) * rs * c.ln1g[l * D + k] + c.ln1b[l * D + k];
            row[k] = h; c.bufB[(size_t)t * D + k] = f2bf(h);
            const float* gw = c.rgw + ((size_t)l * D + k) * 4; const float* ew = c.rew + ((size_t)l * D + k) * 32;
#pragma unroll
            for (int j = 0; j < 4; ++j) lg[j] += h * gw[j];
#pragma unroll
            for (int j = 0; j < 32; ++j) lg[4 + j] += h * ew[j];
        }
        int gi = 0; float gm = lg[0];
#pragma unroll
        for (int j = 1; j < 4; ++j) if (lg[j] > gm) { gm = lg[j]; gi = j; }
        float gs = 0.f;
#pragma unroll
        for (int j = 0; j < 4; ++j) gs += expf(lg[j] - gm);
        const float gp = 1.f / gs;
        float el[8];
#pragma unroll
        for (int j = 0; j < 8; ++j) { float v = 0.f;
#pragma unroll
            for (int g2 = 0; g2 < 4; ++g2) if (g2 == gi) v = lg[4 + g2 * 8 + j];
            el[j] = v; }
        int i0 = 0; float m0 = el[0];
#pragma unroll
        for (int j = 1; j < 8; ++j) if (el[j] > m0) { m0 = el[j]; i0 = j; }
        int i1 = -1; float m1 = -3.0e38f;
#pragma unroll
        for (int j = 0; j < 8; ++j) if (j != i0 && el[j] > m1) { m1 = el[j]; i1 = j; }
        const float p1 = expf(m1 - m0);
        const float w0 = gp * (1.f / (1.f + p1)), w1 = gp * (p1 / (1.f + p1));
        const int e0 = gi * 8 + i0, e1 = gi * 8 + i1;
        c.tok_e[t * 2] = e0; c.tok_e[t * 2 + 1] = e1; c.tok_w[t * 2] = w0; c.tok_w[t * 2 + 1] = w1;
        c.tok_pos[t * 2] = (int)atom_add(c.ctl + CW_CNT + l * 32 + e0, 1u); c.tok_pos[t * 2 + 1] = (int)atom_add(c.ctl + CW_CNT + l * 32 + e1, 1u);
    }
    for (size_t i = gtid; i < (size_t)NE * 512 * D; i += gsz) {
        const int k = (int)(i & 1023), rr = (int)((i >> 10) & 511), e = (int)(i >> 19);
        const int pn = rr >> 8, half = (rr >> 7) & 1, r = rr & 127;
        const float* W = (half ? c.ewu : c.ewg) + ((size_t)(l * NE + e) * D + k) * 256 + 128 * pn + r;
        c.expA[i] = f2bf(*W);
    }
    for (size_t i = gtid; i < (size_t)NE * D * 256; i += gsz) {
        const int k = (int)(i & 255), n = (int)((i >> 8) & 1023), e = (int)(i >> 18);
        c.expB[i] = f2bf(c.ewd[((size_t)(l * NE + e) * 256 + k) * D + n]);
    }
}

DEV int moe_base_tile(const unsigned* cnt, int e) { int b = 0; for (int j = 0; j < e; ++j) b += ((int)cnt[j] + 255) >> 8; return b; }

DEV void p8_gather(const Ctx& c, int l, int gtid, int gsz) {
    const unsigned* cnt = c.ctl + CW_CNT + l * 32;
    for (int i = gtid; i < T * 2 * 128; i += gsz) {
        const int ck = i & 127, tk = i >> 7; const int e = c.tok_e[tk];
        const int slot = moe_base_tile(cnt, e) * 256 + c.tok_pos[tk];
        if (ck == 0) c.tok_slot[tk] = slot;
        const u4* src = (const u4*)(c.bufB + (size_t)(tk >> 1) * D) + ck; u4* dst = (u4*)(c.xg + (size_t)slot * D) + ck;
        *dst = *src;
    }
    for (int i = gtid; i < NE * 256 * 128; i += gsz) {
        const int ck = i & 127, r = (i >> 7) & 255, e = i >> 15; const int n = (int)cnt[e], nt = (n + 255) >> 8;
        const int row = n + r;
        if (row < nt * 256) { unsigned zz = 0u;
#ifndef HOST_EMU
            asm volatile("" : "+v"(zz));
#endif
            u4 z; z.x = z.y = z.z = z.w = zz; *((u4*)(c.xg + (size_t)(moe_base_tile(cnt, e) * 256 + row) * D) + ck) = z; }
    }
}

DEV void p11_ln2(const Ctx& c, int l, int gtid, int gsz) {
    for (int t = gtid; t < T; t += gsz) {
        float* row = c.out + (size_t)t * D;
        const bf16_t* y0 = c.xg + (size_t)c.tok_slot[t * 2] * D; const bf16_t* y1 = c.xg + (size_t)c.tok_slot[t * 2 + 1] * D;
        const float w0 = c.tok_w[t * 2], w1 = c.tok_w[t * 2 + 1];
        float s = 0.f;
        for (int k = 0; k < D; ++k) { const float v = ALPHA * row[k] + (w0 * bf2f(y0[k]) + w1 * bf2f(y1[k])); row[k] = v; s += v; }
        const float mu = s * (1.f / D); float v2 = 0.f;
        for (int k = 0; k < D; ++k) { const float dd = row[k] - mu; v2 += dd * dd; }
        const float rs = 1.f / sqrtf(v2 * (1.f / D) + LN_EPS);
        for (int k = 0; k < D; ++k) { const float h = (row[k] - mu) * rs * c.ln2g[l * D + k] + c.ln2b[l * D + k]; row[k] = h; c.bufA[(size_t)t * D + k] = f2bf(h); }
    }
}

#ifndef HOST_EMU
namespace pg8 {
#define PG8_LAS __attribute__((address_space(3)))
typedef short bf16x8 __attribute__((ext_vector_type(8)));
typedef float f32x4 __attribute__((ext_vector_type(4)));
typedef unsigned u32x4 __attribute__((ext_vector_type(4)));
typedef unsigned u32x2 __attribute__((ext_vector_type(2)));
constexpr int BM = 256, BK = 64, HALF = 128, HTB = HALF * BK * 2, STAGE_BYTES = 8 * HTB, NXCD = 8, WGM = 8;

__host__ __device__ __forceinline__ int lds_byte(int r, int c) { const int st = (r >> 4) * 2 + (c >> 5), rr = r & 15, cc = c & 31, ob = rr * 64 + cc * 2; return st * 1024 + (ob ^ (((ob >> 9) & 1) << 5)); }
__host__ __device__ __forceinline__ void stage_rc(int b, int& R, int& C) { const int st = b / 1024, sb = b % 1024, swz = sb ^ (((sb >> 9) & 1) << 5); R = (st >> 1) * 16 + swz / 64; C = (st & 1) * 32 + (swz % 64) / 2; }

struct Unit { int pm, pn, pa, pb, aux; };
struct Gemm { const bf16_t* A; const bf16_t* Bt; int K; };

__device__ __forceinline__ void tile_of(int wgid, int nM, int nN, int& pm, int& pn) {
    const int nwg = nM * nN; { const int q = nwg / NXCD, r = nwg % NXCD, xcd = wgid % NXCD, off = wgid / NXCD; wgid = (xcd < r ? xcd * (q + 1) : r * (q + 1) + (xcd - r) * q) + off; }
    const int nig = WGM * nN, gid = wgid / nig, fm = gid * WGM, gsz = (nM - fm) < WGM ? (nM - fm) : WGM;
    pm = fm + ((wgid % nig) % gsz); pn = (wgid % nig) / gsz;
}
struct SchedGrid {
    int nM, nN, G, c;
    __device__ __forceinline__ bool next(int i, Unit& u) const { const long L = (long)i * G + c; if (L >= (long)nM * nN) return false; tile_of((int)L, nM, nN, u.pm, u.pn); u.pa = u.pm; u.pb = u.pn; u.aux = 0; return true; }
};
struct SchedBP {
    int nM, nN, G, c;
    __device__ __forceinline__ bool next(int i, Unit& u) const { const long L = (long)(i >> 2) * G + c; if (L >= (long)nM * nN) return false; tile_of((int)L, nM, nN, u.pm, u.pn);
        const int b = i & 3; u.aux = b; u.pa = b * nM + u.pm; u.pb = b * nN + u.pn; return true; }
};
struct SchedMoE {
    const unsigned* cnt; int npn, G, c;
    __device__ __forceinline__ bool next(int i, Unit& u) const {
        const long L = (long)i * G + c; const int rt = (int)(L / npn), pn = (int)(L % npn);
        int e = -1, base = 0;
        for (int j = 0; j < NE; ++j) { const int nt = ((int)cnt[j] + 255) >> 8; if (e < 0 && rt < base + nt) e = j; base += nt; }
        if (e < 0) return false;
        u.pm = rt; u.pa = rt; u.pn = pn; u.pb = e * npn + pn; u.aux = e; return true;
    }
};

constexpr int ULIST_OFF = STAGE_BYTES, ULIST_MAX = 32;
struct SchedLds {
    const PG8_LAS int* ul;
    __device__ __forceinline__ bool next(int i, Unit& u) const {
        if (i >= ULIST_MAX) return false;
        const PG8_LAS int* p = ul + i * 8;
        const int ok = __builtin_amdgcn_readfirstlane(p[0]); if (!ok) return false;
        u.pm = __builtin_amdgcn_readfirstlane(p[1]); u.pn = __builtin_amdgcn_readfirstlane(p[2]); u.pa = __builtin_amdgcn_readfirstlane(p[3]); u.pb = __builtin_amdgcn_readfirstlane(p[4]); u.aux = __builtin_amdgcn_readfirstlane(p[5]);
        return true;
    }
};
template <class Sched> __device__ __forceinline__ SchedLds build_units(PG8_LAS unsigned char* lds, const Sched& S) {
    PG8_LAS int* ul = (PG8_LAS int*)(lds + ULIST_OFF);
    __syncthreads();
    int tx = threadIdx.x; asm volatile("" : "+v"(tx));
    if (tx < ULIST_MAX) { Unit u; u.pm = u.pn = u.pa = u.pb = u.aux = 0; const bool ok = S.next(tx, u); PG8_LAS int* p = ul + tx * 8; p[0] = ok ? 1 : 0; p[1] = u.pm; p[2] = u.pn; p[3] = u.pa; p[4] = u.pb; p[5] = u.aux; }
    __syncthreads();
    SchedLds r; r.ul = ul; return r;
}

__device__ __forceinline__ unsigned cvt_pk_bf16(float lo, float hi) { unsigned r; asm volatile("v_cvt_pk_bf16_f32 %0, %1, %2" : "=v"(r) : "v"(lo), "v"(hi)); return r; }
__device__ __forceinline__ float bflo(unsigned w) { return __builtin_bit_cast(float, w << 16); }
__device__ __forceinline__ float bfhi(unsigned w) { return __builtin_bit_cast(float, w & 0xffff0000u); }
__device__ __forceinline__ float sigm_fast(float x) { return 1.f / (1.f + __expf(-x)); }

#define PG8_EPI_ROWS(...) _Pragma("unroll") for (int ai = 0; ai < 2; ++ai) _Pragma("unroll") for (int m = 0; m < 4; ++m) { const int row = u.pm * BM + ai * HALF + wr * 64 + m * 16 + fr; const int colb = wc * 32 + 4 * fq; \
        __VA_ARGS__ asm volatile("" ::: "memory"); }
#define PG8_FRAGS(...) _Pragma("unroll") for (int bj = 0; bj < 2; ++bj) _Pragma("unroll") for (int n = 0; n < 2; ++n) { const int fo = bj * HALF + n * 16; const f32x4 a = acc[ai][bj][m][n]; __VA_ARGS__ }

struct EpiZ {
    bf16_t* zmix; bf16_t* zgate;
    __device__ __forceinline__ void operator()(const f32x4 (&acc)[2][2][4][2], const Unit& u, int wr, int wc, int fr, int fq) const {
        if (u.pn < NMIX / 256) { PG8_EPI_ROWS( bf16_t* p = zmix + ((unsigned)row * (unsigned)NMIX + (unsigned)(u.pn * BM + colb));
            PG8_FRAGS( u32x2 w; w.x = cvt_pk_bf16(a[0], a[1]); w.y = cvt_pk_bf16(a[2], a[3]); *(u32x2*)(p + fo) = w; ) ) }
        else { PG8_EPI_ROWS( bf16_t* p = zgate + ((unsigned)row * (unsigned)NGATE + (unsigned)(u.pn * BM - NMIX + colb));
            PG8_FRAGS( u32x2 w; w.x = cvt_pk_bf16(sigm_fast(a[0]), sigm_fast(a[1])); w.y = cvt_pk_bf16(sigm_fast(a[2]), sigm_fast(a[3])); *(u32x2*)(p + fo) = w; ) ) }
    }
};
struct EpiBP {
    const bf16_t* zgate; float* part; bf16_t* merged;
    __device__ __forceinline__ void operator()(const f32x4 (&acc)[2][2][4][2], const Unit& u, int wr, int wc, int fr, int fq) const {
        const int b = u.aux;
        PG8_EPI_ROWS( const unsigned eo = (unsigned)row * (unsigned)D + (unsigned)(u.pn * BM + colb);
            const bf16_t* gp = zgate + ((unsigned)row * (unsigned)NGATE + (unsigned)(b * D + u.pn * BM + colb)); float* pp = part + eo; bf16_t* mp = merged + eo;
            PG8_FRAGS( const u32x2 g = *(const u32x2*)(gp + fo);
                f32x4 v; v[0] = bflo(g.x) * a[0]; v[1] = bfhi(g.x) * a[1]; v[2] = bflo(g.y) * a[2]; v[3] = bfhi(g.y) * a[3];
                if (b > 0) v += *(const f32x4*)(pp + fo);
                if (b < 3) *(f32x4*)(pp + fo) = v; else { u32x2 w; w.x = cvt_pk_bf16(v[0], v[1]); w.y = cvt_pk_bf16(v[2], v[3]); *(u32x2*)(mp + fo) = w; } ) )
    }
};
struct EpiRes {
    float* out;
    __device__ __forceinline__ void operator()(const f32x4 (&acc)[2][2][4][2], const Unit& u, int wr, int wc, int fr, int fq) const {
        PG8_EPI_ROWS( float* pp = out + ((unsigned)row * (unsigned)D + (unsigned)(u.pn * BM + colb));
            PG8_FRAGS( const f32x4 h = *(const f32x4*)(pp + fo); *(f32x4*)(pp + fo) = h * ALPHA + a; ) )
    }
};
struct EpiHid {
    bf16_t* hid;
    __device__ __forceinline__ void operator()(const f32x4 (&acc)[2][2][4][2], const Unit& u, int wr, int wc, int fr, int fq) const {
        PG8_EPI_ROWS( bf16_t* p = hid + ((unsigned)row * 256u + (unsigned)(u.pn * 128 + colb));
            _Pragma("unroll") for (int n = 0; n < 2; ++n) { const f32x4 g = acc[ai][0][m][n]; const f32x4 up = acc[ai][1][m][n];
                u32x2 w; w.x = cvt_pk_bf16(g[0] * sigm_fast(g[0]) * up[0], g[1] * sigm_fast(g[1]) * up[1]); w.y = cvt_pk_bf16(g[2] * sigm_fast(g[2]) * up[2], g[3] * sigm_fast(g[3]) * up[3]);
                *(u32x2*)(p + n * 16) = w; } )
    }
};
struct EpiY {
    bf16_t* y;
    __device__ __forceinline__ void operator()(const f32x4 (&acc)[2][2][4][2], const Unit& u, int wr, int wc, int fr, int fq) const {
        PG8_EPI_ROWS( bf16_t* p = y + ((unsigned)row * (unsigned)D + (unsigned)(u.pn * BM + colb));
            PG8_FRAGS( u32x2 w; w.x = cvt_pk_bf16(a[0], a[1]); w.y = cvt_pk_bf16(a[2], a[3]); *(u32x2*)(p + fo) = w; ) )
    }
};

template <class Epi, class Sched>
__device__ __forceinline__ void gemm_phase(PG8_LAS unsigned char* lds, const Gemm g, const Sched& S, const Epi& E) {
    int tid_ = threadIdx.x; asm volatile("" : "+v"(tid_)); const int tid = tid_, wid = __builtin_amdgcn_readfirstlane(tid >> 6), lane = tid & 63, wr = wid >> 2, wc = wid & 3, fr = lane & 15, fq = lane >> 4;
    const int K = g.K, nt = K / BK;
    unsigned voffA[2];
#pragma unroll
    for (int i = 0; i < 2; ++i) { int R, C; stage_rc(tid * 16 + i * 8192, R, C); voffA[i] = (unsigned)(R * K + C) * 2u; }
    const size_t kstep = (size_t)(BK * 2);
    const size_t hstep = (size_t)HALF * K * 2;
    const size_t tstep = 2 * hstep;
    const unsigned ldsw = (unsigned)wid * 1024u;
    const int aoff = lds_byte(wr * 64 + fr, fq * 8), boff = lds_byte(wc * 32 + fr, fq * 8);
#define PG8_SA(b, h) (((b) * 2 + (h)) * HTB)
#define PG8_SB(b, h) ((4 + (b) * 2 + (h)) * HTB)
#define PG8_STAGE(bufoff, gbase) do { _Pragma("unroll") for (int _i = 0; _i < 2; ++_i) \
        __builtin_amdgcn_global_load_lds((const unsigned*)((const char*)(gbase) + voffA[_i]), (PG8_LAS unsigned*)(lds + (bufoff) + ldsw + _i * 8192), 16, 0, 0); } while (0)
#define PG8_LDA(dst, b, h) do { _Pragma("unroll") for (int m = 0; m < 4; ++m) _Pragma("unroll") for (int k = 0; k < 2; ++k) dst[m][k] = *(const PG8_LAS bf16x8*)(lds + PG8_SA(b, h) + aoff + m * 2048 + k * 1024); } while (0)
#define PG8_LDB(dst, b, h) do { _Pragma("unroll") for (int n = 0; n < 2; ++n) _Pragma("unroll") for (int k = 0; k < 2; ++k) dst[n][k] = *(const PG8_LAS bf16x8*)(lds + PG8_SB(b, h) + boff + n * 2048 + k * 1024); } while (0)
#define PG8_MMA(ai, bj, At, Bt) do { __builtin_amdgcn_s_setprio(1); _Pragma("unroll") for (int m = 0; m < 4; ++m) _Pragma("unroll") for (int n = 0; n < 2; ++n) _Pragma("unroll") for (int k = 0; k < 2; ++k) \
        acc[ai][bj][m][n] = __builtin_amdgcn_mfma_f32_16x16x32_bf16(Bt[n][k], At[m][k], acc[ai][bj][m][n], 0, 0, 0); __builtin_amdgcn_s_setprio(0); } while (0)
#define PG8_WAIT_V(n) asm volatile("s_waitcnt vmcnt(" #n ")" ::: "memory")
#define PG8_WAIT_L(n) asm volatile("s_waitcnt lgkmcnt(" #n ")" ::: "memory")
#define PG8_BAR __builtin_amdgcn_s_barrier()
#define PG8_SCHED __builtin_amdgcn_sched_barrier(0)
    Unit cur, nxt; int ui = 0;
    if (!S.next(0, cur)) return;
    f32x4 acc[2][2][4][2];
#pragma unroll
    for (int a = 0; a < 2; ++a)
#pragma unroll
        for (int b = 0; b < 2; ++b)
#pragma unroll
            for (int m = 0; m < 4; ++m)
#pragma unroll
                for (int n = 0; n < 2; ++n) acc[a][b][m][n] = (f32x4){0.f, 0.f, 0.f, 0.f};
    bf16x8 At[4][2], B0[2][2], B1[2][2];
    const char* cA = (const char*)g.A + (size_t)cur.pa * tstep; const char* cB = (const char*)g.Bt + (size_t)cur.pb * tstep;
    PG8_STAGE(PG8_SB(0, 0), cB); PG8_STAGE(PG8_SB(0, 1), cB + hstep); PG8_STAGE(PG8_SA(0, 0), cA); PG8_STAGE(PG8_SA(0, 1), cA + hstep);
    if (wr == 1) PG8_BAR;
    PG8_WAIT_V(2); PG8_BAR;
    PG8_STAGE(PG8_SB(1, 0), cB + kstep); PG8_STAGE(PG8_SA(1, 0), cA + kstep); PG8_STAGE(PG8_SB(1, 1), cB + hstep + kstep);
    PG8_WAIT_V(6); PG8_BAR;
    for (;;) {
        const bool has_next = S.next(ui + 1, nxt);
        const char* nA = has_next ? (const char*)g.A + (size_t)nxt.pa * tstep : cA; const char* nB = has_next ? (const char*)g.Bt + (size_t)nxt.pb * tstep : cB;
        _Pragma("nounroll") for (int t = 0; t < nt; t += 2) {
            const bool last = (t == nt - 2);
            const char* a1 = cA + (size_t)(t + 1) * kstep;
            const char* a2 = last ? nA : cA + (size_t)(t + 2) * kstep; const char* b2 = last ? nB : cB + (size_t)(t + 2) * kstep;
            const char* a3 = a2 + kstep; const char* b3 = b2 + kstep;
            PG8_LDB(B0, 0, 0); PG8_LDB(B1, 0, 1); PG8_SCHED; PG8_LDA(At, 0, 0); PG8_STAGE(PG8_SA(1, 1), a1 + hstep);
            PG8_WAIT_V(8); PG8_WAIT_L(0); PG8_BAR; PG8_MMA(0, 0, At, B0); PG8_MMA(0, 1, At, B1); PG8_BAR; PG8_SCHED;
            PG8_LDA(At, 0, 1); PG8_STAGE(PG8_SB(0, 0), b2); PG8_STAGE(PG8_SB(0, 1), b2 + hstep); PG8_STAGE(PG8_SA(0, 0), a2);
            PG8_WAIT_V(8); PG8_WAIT_L(0); PG8_BAR; PG8_MMA(1, 0, At, B0); PG8_MMA(1, 1, At, B1); PG8_BAR; PG8_SCHED;
            PG8_LDB(B0, 1, 0); PG8_LDB(B1, 1, 1); PG8_SCHED; PG8_LDA(At, 1, 0); PG8_STAGE(PG8_SA(0, 1), a2 + hstep);
            PG8_WAIT_V(8); PG8_WAIT_L(0); PG8_BAR; PG8_MMA(0, 0, At, B0); PG8_MMA(0, 1, At, B1); PG8_BAR; PG8_SCHED;
            PG8_LDA(At, 1, 1); PG8_STAGE(PG8_SB(1, 0), b3); PG8_STAGE(PG8_SB(1, 1), b3 + hstep); PG8_STAGE(PG8_SA(1, 0), a3);
            PG8_WAIT_V(8); PG8_WAIT_L(0); PG8_BAR; PG8_MMA(1, 0, At, B0); PG8_MMA(1, 1, At, B1); PG8_BAR; PG8_SCHED;
        }
        if (wr == 0) PG8_BAR;
        E(acc, cur, wr, wc, fr, fq);
        if (!has_next) break;
#pragma unroll
        for (int a = 0; a < 2; ++a)
#pragma unroll
            for (int b = 0; b < 2; ++b)
#pragma unroll
                for (int m = 0; m < 4; ++m)
#pragma unroll
                    for (int n = 0; n < 2; ++n) acc[a][b][m][n] = (f32x4){0.f, 0.f, 0.f, 0.f};
        cur = nxt; cA = nA; cB = nB; ++ui;
        if (wr == 1) PG8_BAR;
    }
    PG8_WAIT_V(0);
    PG8_BAR;
#undef PG8_SA
#undef PG8_SB
#undef PG8_STAGE
#undef PG8_LDA
#undef PG8_LDB
#undef PG8_MMA
#undef PG8_WAIT_V
#undef PG8_WAIT_L
#undef PG8_BAR
#undef PG8_SCHED
}
}

namespace cg = cooperative_groups;
constexpr int LDS_BYTES = 147456;

__global__ void __launch_bounds__(512, 2) mega_fwd(Ctx c) {
    extern __shared__ __attribute__((aligned(16))) unsigned char lds_raw[];
    PG8_LAS unsigned char* lds = (PG8_LAS unsigned char*)lds_raw;
    cg::grid_group grid = cg::this_grid();
    const int gsz = gridDim.x * 512, G = gridDim.x, bx = blockIdx.x;
#define FRESH_GTID int gtid = blockIdx.x * 512 + threadIdx.x; asm volatile("" : "+v"(gtid))

    { FRESH_GTID; p0_prologue(c, gtid, gsz); }
    grid.sync();
    for (int l = 0; l < 2; ++l) {
        {
            pg8::Gemm g{c.bufA, c.w_in_t + (size_t)l * NIN * D, D}; pg8::SchedGrid Sd{T / 256, NIN / 256, G, bx}; pg8::EpiZ E{c.zmix, c.zgate};
            pg8::gemm_phase(lds, g, pg8::build_units(lds, Sd), E);
        }
        grid.sync();
        { FRESH_GTID; p2_rope_stats(c, gtid, gsz); }
        grid.sync();
        { FRESH_GTID; p2b_chunk_local(c, l, gtid, gsz); }
        grid.sync();
        { FRESH_GTID; p3_scan(c, gtid, gsz); }
        grid.sync();
        { FRESH_GTID; p4_mixers(c, l, gtid, gsz); }
        grid.sync();
        {
            pg8::Gemm g{c.bufB, c.bp_t + (size_t)l * 4 * D * 256, 256}; pg8::SchedBP Sd{T / 256, D / 256, G, bx}; pg8::EpiBP E{c.zgate, c.part, c.bufA};
            pg8::gemm_phase(lds, g, pg8::build_units(lds, Sd), E);
        }
        grid.sync();
        {
            pg8::Gemm g{c.bufA, c.wout_t + (size_t)l * D * D, D}; pg8::SchedGrid Sd{T / 256, D / 256, G, bx}; pg8::EpiRes E{c.out};
            pg8::gemm_phase(lds, g, pg8::build_units(lds, Sd), E);
        }
        grid.sync();
        { FRESH_GTID; p7_ln_router(c, l, gtid, gsz); }
        grid.sync();
        { FRESH_GTID; p8_gather(c, l, gtid, gsz); }
        grid.sync();
        {
            pg8::Gemm g{c.xg, c.expA, D}; pg8::SchedMoE Sd{c.ctl + CW_CNT + l * 32, 2, G, bx}; pg8::EpiHid E{c.hid};
            pg8::gemm_phase(lds, g, pg8::build_units(lds, Sd), E);
        }
        grid.sync();
        {
            pg8::Gemm g{c.hid, c.expB, 256}; pg8::SchedMoE Sd{c.ctl + CW_CNT + l * 32, 4, G, bx}; pg8::EpiY E{c.xg};
            pg8::gemm_phase(lds, g, pg8::build_units(lds, Sd), E);
        }
        grid.sync();
        { FRESH_GTID; p11_ln2(c, l, gtid, gsz); }
        if (l == 0) grid.sync();
    }
}

extern "C" void kernel_launch(void* const* d_in, const int* in_sizes, int n_in, void* d_out, int out_size, void* d_ws, size_t ws_size, hipStream_t stream) {
    static int grid = 0;
    if (grid == 0) {
        if (n_in != 29 || out_size != T * D || ws_size < WS_END) { fprintf(stderr, "kernel_launch: unexpected shapes (n_in %d out %d ws %zu need %zu)\n", n_in, out_size, ws_size, (size_t)WS_END); grid = -1; return; }
        int dev = 0, cus = 0, per_cu = 0;
        hipGetDevice(&dev); hipDeviceGetAttribute(&cus, hipDeviceAttributeMultiprocessorCount, dev);
        hipFuncSetAttribute((const void*)mega_fwd, hipFuncAttributeMaxDynamicSharedMemorySize, LDS_BYTES);
        hipOccupancyMaxActiveBlocksPerMultiprocessor(&per_cu, (const void*)mega_fwd, 512, LDS_BYTES);
        if (per_cu < 1) { fprintf(stderr, "kernel_launch: occupancy query says %d blocks per CU\n", per_cu); grid = -1; return; }
        grid = cus;
    }
    if (grid < 0) return;
    hipMemsetAsync((char*)d_ws + WS_CTL, 0, CTL_BYTES, stream);
    Ctx c; memset(&c, 0, sizeof(c)); ctx_fill(c, d_in, d_out, d_ws);
    void* args[] = {&c};
    hipError_t e = hipLaunchCooperativeKernel((const void*)mega_fwd, dim3(grid), dim3(512), args, LDS_BYTES, stream);
    if (e != hipSuccess) fprintf(stderr, "cooperative launch failed: %s (grid %d)\n", hipGetErrorString(e), grid);
}
#endif
```

```cpp
#ifndef HOST_EMU
#include <hip/hip_runtime.h>
#include <hip/hip_cooperative_groups.h>
#include <cstdio>
#include <cstdint>
#include <cstring>
#define DEV __device__ __forceinline__
#else
#include <cmath>
#include <cstdio>
#include <cstdint>
#include <cstring>
#define DEV inline
#endif

typedef unsigned short bf16_t;
struct __attribute__((aligned(16))) u4 { unsigned x, y, z, w; };
#ifndef SEQ
#define SEQ 8192
#endif
constexpr int NB = 2, S = SEQ, T = NB * S, D = 1024, NIN = 6656, NMIX = 2560, NGATE = 4096, NCH = S / 128, NCHT = T / 128;
constexpr int NE = 32, SLOTCAP = 2 * T + NE * 256;
constexpr int C_SCB = 0, C_SCC = 256, C_SCX = 512, C_LRX = 768, C_SGU = 1024, C_SGV = 1280, C_RQ = 1536, C_RK = 1792, C_RV = 2048, C_RG = 2304;
constexpr float ALPHA = 1.4142135623730951f, LN_EPS = 1e-5f;

struct Ctx {
    const float* x; const int* pos; const float* w_in; const float* sc_w; const float* sc_b; const float* lru_cw; const float* lru_cb;
    const float* lru_wr; const float* lru_br; const float* lru_wi; const float* lru_bi; const float* lru_lam; const float* sg_ng; const float* sg_ws; const float* sg_bs;
    const float* ret_ng; const float* bproj; const float* wout; const float* ln1g; const float* ln1b; const float* rgw; const float* rgb; const float* rew; const float* reb;
    const float* ewg; const float* ewu; const float* ewd; const float* ln2g; const float* ln2b;
    float* out;
    unsigned* ctl; bf16_t* w_in_t; bf16_t* bp_t; bf16_t* wout_t; float* ropec; float* ropes; float* rstate; float* lruA; float* lruH; float* lruC; float* sgstat;
    int* tok_e; int* tok_pos; float* tok_w; int* tok_slot;
    bf16_t* bufA; bf16_t* bufB; bf16_t* zmix; bf16_t* zgate; float* part; bf16_t* expA; bf16_t* expB; bf16_t* xg; bf16_t* hid;
    bf16_t* wr_hi; bf16_t* wr_lo; bf16_t* hlo; bf16_t* sgw; bf16_t* lwrT; bf16_t* lwiT;
};

constexpr size_t MiB = 1u << 20;
constexpr size_t cmax(size_t a, size_t b) { return a > b ? a : b; }
constexpr size_t WS_CTL = 0, CTL_BYTES = 1 * MiB;
constexpr size_t WS_WIN = WS_CTL + CTL_BYTES;
constexpr size_t WS_BP = WS_WIN + (size_t)2 * NIN * D * 2;
constexpr size_t WS_WOUT = WS_BP + (size_t)2 * 4 * D * 256 * 2;
constexpr size_t WS_WRH = WS_WOUT + (size_t)2 * D * D * 2;
constexpr size_t WS_WRL = WS_WRH + (size_t)2 * 48 * D * 2;
constexpr size_t WS_SGW = WS_WRL + (size_t)2 * 48 * D * 2;
constexpr size_t WS_LWR = WS_SGW + (size_t)2 * 4 * 128 * 128 * 2;
constexpr size_t WS_LWI = WS_LWR + (size_t)2 * 4 * 4096 * 2;
constexpr size_t WS_ROPEC = WS_LWI + (size_t)2 * 4 * 4096 * 2;
constexpr size_t WS_ROPES = WS_ROPEC + (size_t)T * 32 * 4;
constexpr size_t WS_RSTATE = WS_ROPES + (size_t)T * 32 * 4;
constexpr size_t WS_LRUA = WS_RSTATE + (size_t)NB * NCH * 4 * 4096 * 4;
constexpr size_t WS_LRUH = WS_LRUA + (size_t)NCHT * 256 * 4;
constexpr size_t WS_LRUC = WS_LRUH + (size_t)NCHT * 256 * 4;
constexpr size_t WS_SGST = WS_LRUC + (size_t)NCHT * 256 * 4;
constexpr size_t WS_TOKE = WS_SGST + (size_t)T * 4 * 2 * 4;
constexpr size_t WS_TOKP = WS_TOKE + (size_t)T * 2 * 4;
constexpr size_t WS_TOKW = WS_TOKP + (size_t)T * 2 * 4;
constexpr size_t WS_TOKS = WS_TOKW + (size_t)T * 2 * 4;
constexpr size_t WS_BUFA = WS_TOKS + (size_t)T * 2 * 4;
constexpr size_t WS_BUFB = WS_BUFA + (size_t)T * D * 2;
constexpr size_t WS_ZR = WS_BUFB + (size_t)T * D * 2;
constexpr size_t ZR_ZGATE = (size_t)T * NMIX * 2;
constexpr size_t ZR_EXPB = (size_t)NE * 512 * D * 2;
constexpr size_t ZR_XG = ZR_EXPB + (size_t)NE * D * 256 * 2;
constexpr size_t ZR_HID = ZR_XG + (size_t)SLOTCAP * D * 2;
constexpr size_t ZR_HLO = ZR_HID + (size_t)SLOTCAP * 256 * 2;
constexpr size_t ZR_BYTES = cmax((size_t)T * NIN * 2, ZR_HLO + (size_t)T * D * 2);
constexpr size_t WS_END = WS_ZR + ZR_BYTES;
constexpr int CW_CNT = 1024;

inline void ctx_fill(Ctx& c, void* const* d_in, void* d_out, void* d_ws) {
    const float* const* f = (const float* const*)d_in;
    c.x = f[0]; c.pos = (const int*)d_in[1]; c.w_in = f[2]; c.sc_w = f[3]; c.sc_b = f[4]; c.lru_cw = f[5]; c.lru_cb = f[6]; c.lru_wr = f[7]; c.lru_br = f[8]; c.lru_wi = f[9];
    c.lru_bi = f[10]; c.lru_lam = f[11]; c.sg_ng = f[12]; c.sg_ws = f[13]; c.sg_bs = f[14]; c.ret_ng = f[15]; c.bproj = f[16]; c.wout = f[17]; c.ln1g = f[18]; c.ln1b = f[19];
    c.rgw = f[20]; c.rgb = f[21]; c.rew = f[22]; c.reb = f[23]; c.ewg = f[24]; c.ewu = f[25]; c.ewd = f[26]; c.ln2g = f[27]; c.ln2b = f[28];
    c.out = (float*)d_out;
    unsigned char* w = (unsigned char*)d_ws;
    c.ctl = (unsigned*)(w + WS_CTL); c.w_in_t = (bf16_t*)(w + WS_WIN); c.bp_t = (bf16_t*)(w + WS_BP); c.wout_t = (bf16_t*)(w + WS_WOUT);
    c.ropec = (float*)(w + WS_ROPEC); c.ropes = (float*)(w + WS_ROPES); c.rstate = (float*)(w + WS_RSTATE); c.lruA = (float*)(w + WS_LRUA); c.lruH = (float*)(w + WS_LRUH);
    c.lruC = (float*)(w + WS_LRUC); c.sgstat = (float*)(w + WS_SGST); c.tok_e = (int*)(w + WS_TOKE); c.tok_pos = (int*)(w + WS_TOKP); c.tok_w = (float*)(w + WS_TOKW);
    c.tok_slot = (int*)(w + WS_TOKS); c.bufA = (bf16_t*)(w + WS_BUFA); c.bufB = (bf16_t*)(w + WS_BUFB);
    c.zmix = (bf16_t*)(w + WS_ZR); c.zgate = (bf16_t*)(w + WS_ZR + ZR_ZGATE); c.part = (float*)(w + WS_ZR);
    c.expA = (bf16_t*)(w + WS_ZR); c.expB = (bf16_t*)(w + WS_ZR + ZR_EXPB); c.xg = (bf16_t*)(w + WS_ZR + ZR_XG); c.hid = (bf16_t*)(w + WS_ZR + ZR_HID);
    c.wr_hi = (bf16_t*)(w + WS_WRH); c.wr_lo = (bf16_t*)(w + WS_WRL); c.hlo = (bf16_t*)(w + WS_ZR + ZR_HLO);
    c.sgw = (bf16_t*)(w + WS_SGW); c.lwrT = (bf16_t*)(w + WS_LWR); c.lwiT = (bf16_t*)(w + WS_LWI);
}

DEV float bf2f(bf16_t v) { unsigned u = (unsigned)v << 16; float f; memcpy(&f, &u, 4); return f; }
DEV bf16_t f2bf(float f) { unsigned u; memcpy(&u, &f, 4); return (bf16_t)((u + 0x7fffu + ((u >> 16) & 1u)) >> 16); }
DEV float sigm(float x) { return 1.f / (1.f + expf(-x)); }
DEV float silu_(float x) { return x * sigm(x); }
DEV float gelu_(float x) { return 0.5f * x * (1.f + tanhf(0.7978845608028654f * (x + 0.044715f * x * x * x))); }
DEV float softplus_(float x) { return x > 20.f ? x : log1pf(expf(x)); }
DEV float ret_lg(int hd) { return log1pf(-exp2f(-5.f - (float)hd)); }
DEV unsigned atom_add(unsigned* p, unsigned v) {
#ifndef HOST_EMU
    return atomicAdd(p, v);
#else
    return __atomic_fetch_add(p, v, __ATOMIC_RELAXED);
#endif
}

DEV void conv_wT(const float* W, int K, int N, bf16_t* WT, int gtid, int gsz) {
    const size_t n_el = (size_t)K * N;
    for (size_t i = gtid; i < n_el; i += gsz) { const int n = (int)(i / K), k = (int)(i % K); WT[i] = f2bf(W[(size_t)k * N + n]); }
}
DEV void p0_prologue(const Ctx& c, int gtid, int gsz) {
    for (int l = 0; l < 2; ++l) {
        conv_wT(c.w_in + (size_t)l * D * NIN, D, NIN, c.w_in_t + (size_t)l * NIN * D, gtid, gsz);
        for (int b = 0; b < 4; ++b) conv_wT(c.bproj + ((size_t)l * 4 + b) * 256 * D, 256, D, c.bp_t + ((size_t)l * 4 + b) * D * 256, gtid, gsz);
        conv_wT(c.wout + (size_t)l * D * D, D, D, c.wout_t + (size_t)l * D * D, gtid, gsz);
    }
    for (int i = gtid; i < T * 32; i += gsz) {
        const int t = i >> 5, j = i & 31;
        const float inv = exp2f(-(float)j * (13.287712379549449f / 32.f));
        const float ang = (float)c.pos[t] * inv;
        c.ropec[i] = cosf(ang); c.ropes[i] = sinf(ang);
    }
    for (size_t i = gtid; i < (size_t)T * D; i += gsz) { const float v = c.x[i]; c.out[i] = v; c.bufA[i] = f2bf(v); }
}

DEV void p2_rope_stats(const Ctx& c, int gtid, int gsz) {
    for (int i = gtid; i < T * 4 * 32; i += gsz) {
        const int t = i >> 7, hd = (i >> 5) & 3, j = i & 31;
        const float cs = c.ropec[t * 32 + j], sn = c.ropes[t * 32 + j];
        bf16_t* q = c.zmix + (size_t)t * NMIX + C_RQ + hd * 64 + j; bf16_t* k = c.zmix + (size_t)t * NMIX + C_RK + hd * 64 + j;
        const float q1 = bf2f(q[0]), q2 = bf2f(q[32]), k1 = bf2f(k[0]), k2 = bf2f(k[32]);
        q[0] = f2bf(q1 * cs - q2 * sn); q[32] = f2bf(q2 * cs + q1 * sn);
        k[0] = f2bf((k1 * cs - k2 * sn) * 0.125f); k[32] = f2bf((k2 * cs + k1 * sn) * 0.125f);
    }
    for (int i = gtid; i < T * 4; i += gsz) {
        const int t = i >> 2, g = i & 3; const bf16_t* zv = c.zmix + (size_t)t * NMIX + C_SGV + g * 64;
        float s = 0.f; for (int d = 0; d < 64; ++d) s += gelu_(bf2f(zv[d]));
        const float mu = s * (1.f / 64.f); float q = 0.f;
        for (int d = 0; d < 64; ++d) { const float v = gelu_(bf2f(zv[d])) - mu; q += v * v; }
        c.sgstat[i * 2] = mu; c.sgstat[i * 2 + 1] = 1.f / sqrtf(q * (1.f / 64.f) + LN_EPS);
    }
}

DEV void lru_au(const Ctx& c, int l, int t, int ch, float& a, float& u) {
    const int hd = ch >> 6, e = ch & 63, s = t % S;
    const float* cw = c.lru_cw + l * 4 * 256; const float* cb = c.lru_cb + l * 256;
    const float* wr = c.lru_wr + (size_t)(l * 4 + hd) * 4096; const float* wi = c.lru_wi + (size_t)(l * 4 + hd) * 4096;
    float rp = c.lru_br[l * 256 + ch], ip = c.lru_bi[l * 256 + ch], xce = 0.f;
    for (int d = 0; d < 64; ++d) {
        const int cc = hd * 64 + d; float xc = cb[cc];
        for (int j = 0; j < 4; ++j) { const int sj = s - 3 + j; if (sj >= 0) xc += cw[j * 256 + cc] * bf2f(c.zmix[(size_t)(t - 3 + j) * NMIX + C_LRX + cc]); }
        rp += xc * wr[d * 64 + e]; ip += xc * wi[d * 64 + e];
        if (d == e) xce = xc;
    }
    const float r = sigm(rp), ig = sigm(ip);
    const float la = -8.f * r * softplus_(-c.lru_lam[l * 256 + ch]);
    a = expf(la); u = sqrtf(-expm1f(2.f * la)) * (ig * xce);
}

DEV void p2b_chunk_local(const Ctx& c, int l, int gtid, int gsz) {
    for (int i = gtid; i < NCHT * 4 * 4096; i += gsz) {
        const int e = i & 63, d = (i >> 6) & 63, hd = (i >> 12) & 3, gc = i >> 14; const int t0 = gc * 128;
        const float lg = ret_lg(hd); float acc = 0.f;
        for (int m = 0; m < 128; ++m) {
            const bf16_t* row = c.zmix + (size_t)(t0 + m) * NMIX;
            acc += bf2f(row[C_RK + hd * 64 + d]) * bf2f(row[C_RV + hd * 64 + e]) * expf((float)(127 - m) * lg);
        }
        c.rstate[i] = acc;
    }
    for (int i = gtid; i < NCHT * 256; i += gsz) {
        const int ch = i & 255, gc = i >> 8; float A = 1.f, H = 0.f;
        for (int m = 0; m < 128; ++m) { float a, u; lru_au(c, l, gc * 128 + m, ch, a, u); H = a * H + u; A *= a; }
        c.lruA[i] = A; c.lruH[i] = H;
    }
}

DEV void p3_scan(const Ctx& c, int gtid, int gsz) {
    for (int i = gtid; i < NB * 4 * 4096; i += gsz) {
        const int de = i & 4095, hd = (i >> 12) & 3, b = i >> 14;
        const float cd = expf(128.f * ret_lg(hd)); float st = 0.f;
        for (int ci = 0; ci < NCH; ++ci) { float* p = c.rstate + ((size_t)((b * NCH + ci) * 4 + hd) * 4096 + de); const float kv = *p; *p = st; st = cd * st + kv; }
    }
    for (int i = gtid; i < NB * 256; i += gsz) {
        const int ch = i & 255, b = i >> 8; float carry = 0.f;
        for (int ci = 0; ci < NCH; ++ci) { const int j = (b * NCH + ci) * 256 + ch; c.lruC[j] = carry; carry = c.lruA[j] * carry + c.lruH[j]; }
    }
}

DEV void p4_mixers(const Ctx& c, int l, int gtid, int gsz) {
    bf16_t* br0 = c.bufB; bf16_t* br1 = c.bufB + (size_t)T * 256; bf16_t* br2 = c.bufB + (size_t)2 * T * 256; bf16_t* br3 = c.bufB + (size_t)3 * T * 256;
    for (int i = gtid; i < T * 256; i += gsz) {
        const int ch = i & 255, t = i >> 8, s = t % S; float acc = c.sc_b[l * 256 + ch];
        for (int j = 0; j < 3; ++j) { const int sj = s - 2 + j; if (sj >= 0) { const bf16_t* row = c.zmix + (size_t)(t - 2 + j) * NMIX; acc += c.sc_w[(l * 3 + j) * 256 + ch] * (bf2f(row[C_SCC + ch]) * bf2f(row[C_SCX + ch])); } }
        br0[i] = f2bf(bf2f(c.zmix[(size_t)t * NMIX + C_SCB + ch]) * acc);
    }
    for (int i = gtid; i < NCHT * 256; i += gsz) {
        const int ch = i & 255, gc = i >> 8; float h = c.lruC[i];
        for (int m = 0; m < 128; ++m) { float a, u; lru_au(c, l, gc * 128 + m, ch, a, u); h = a * h + u; br1[(size_t)(gc * 128 + m) * 256 + ch] = f2bf(h); }
    }
    for (int i = gtid; i < T * 256; i += gsz) {
        const int ch = i & 255, t = i >> 8, g = ch >> 6, tt = t & 127, t0 = t - tt;
        const float* ws = c.sg_ws + ((size_t)(l * 4 + g) * 128 + tt) * 128; const float ng = c.sg_ng[l * 256 + ch];
        float sv = c.sg_bs[(l * 4 + g) * 128 + tt];
        for (int s2 = 0; s2 <= tt; ++s2) {
            const float mu = c.sgstat[((t0 + s2) * 4 + g) * 2], rs = c.sgstat[((t0 + s2) * 4 + g) * 2 + 1];
            sv += ws[s2] * ((gelu_(bf2f(c.zmix[(size_t)(t0 + s2) * NMIX + C_SGV + ch])) - mu) * rs * ng);
        }
        br2[i] = f2bf(gelu_(bf2f(c.zmix[(size_t)t * NMIX + C_SGU + ch])) * sv);
    }
    for (int i = gtid; i < T * 4; i += gsz) {
        const int hd = i & 3, t = i >> 2, n = t & 127, t0 = t - n, gc = t >> 7;
        const float lg = ret_lg(hd);
        float q[64], o[64];
        const bf16_t* qrow = c.zmix + (size_t)t * NMIX + C_RQ + hd * 64;
#pragma unroll
        for (int d = 0; d < 64; ++d) { q[d] = bf2f(qrow[d]); o[d] = 0.f; }
        for (int m = 0; m <= n; ++m) {
            const bf16_t* row = c.zmix + (size_t)(t0 + m) * NMIX; float sc = 0.f;
#pragma unroll
            for (int d = 0; d < 64; ++d) sc += q[d] * bf2f(row[C_RK + hd * 64 + d]);
            sc *= expf((float)(n - m) * lg);
#pragma unroll
            for (int e = 0; e < 64; ++e) o[e] += sc * bf2f(row[C_RV + hd * 64 + e]);
        }
        const float qd = expf((float)(n + 1) * lg); const float* prev = c.rstate + (size_t)(gc * 4 + hd) * 4096;
        for (int d = 0; d < 64; ++d) { const float qq = bf2f(qrow[d]) * qd;
#pragma unroll
            for (int e = 0; e < 64; ++e) o[e] += qq * prev[d * 64 + e]; }
        float s = 0.f;
#pragma unroll
        for (int e = 0; e < 64; ++e) s += o[e];
        const float mu = s * (1.f / 64.f); float v2 = 0.f;
#pragma unroll
        for (int e = 0; e < 64; ++e) { const float dd = o[e] - mu; v2 += dd * dd; }
        const float rs = 1.f / sqrtf(v2 * (1.f / 64.f) + LN_EPS);
#pragma unroll
        for (int e = 0; e < 64; ++e) { const float on = (o[e] - mu) * rs * c.ret_ng[l * 256 + hd * 64 + e];
            br3[(size_t)t * 256 + hd * 64 + e] = f2bf(silu_(bf2f(c.zmix[(size_t)t * NMIX + C_RG + hd * 64 + e])) * on); }
    }
}

DEV void p7_ln_router(const Ctx& c, int l, int gtid, int gsz) {
    for (int t = gtid; t < T; t += gsz) {
        float* row = c.out + (size_t)t * D; float s = 0.f;
        for (int k = 0; k < D; ++k) s += row[k];
        const float mu = s * (1.f / D); float v2 = 0.f;
        for (int k = 0; k < D; ++k) { const float dd = row[k] - mu; v2 += dd * dd; }
        const float rs = 1.f / sqrtf(v2 * (1.f / D) + LN_EPS);
        float lg[36];
#pragma unroll
        for (int j = 0; j < 4; ++j) lg[j] = c.rgb[l * 4 + j];
#pragma unroll
        for (int j = 0; j < 32; ++j) lg[4 + j] = c.reb[l * 32 + j];
        for (int k = 0; k < D; ++k) {
            const float h = (row[k] - mu) * rs * c.ln1g[l * D + k] + c.ln1b[l * D + k];
            row[k] = h; c.bufB[(size_t)t * D + k] = f2bf(h);
            const float* gw = c.rgw + ((size_t)l * D + k) * 4; const float* ew = c.rew + ((size_t)l * D + k) * 32;
#pragma unroll
            for (int j = 0; j < 4; ++j) lg[j] += h * gw[j];
#pragma unroll
            for (int j = 0; j < 32; ++j) lg[4 + j] += h * ew[j];
        }
        int gi = 0; float gm = lg[0];
#pragma unroll
        for (int j = 1; j < 4; ++j) if (lg[j] > gm) { gm = lg[j]; gi = j; }
        float gs = 0.f;
#pragma unroll
        for (int j = 0; j < 4; ++j) gs += expf(lg[j] - gm);
        const float gp = 1.f / gs;
        float el[8];
#pragma unroll
        for (int j = 0; j < 8; ++j) { float v = 0.f;
#pragma unroll
            for (int g2 = 0; g2 < 4; ++g2) if (g2 == gi) v = lg[4 + g2 * 8 + j];
            el[j] = v; }
        int i0 = 0; float m0 = el[0];
#pragma unroll
        for (int j = 1; j < 8; ++j) if (el[j] > m0) { m0 = el[j]; i0 = j; }
        int i1 = -1; float m1 = -3.0e38f;
#pragma unroll
        for (int j = 0; j < 8; ++j) if (j != i0 && el[j] > m1) { m1 = el[j]; i1 = j; }
        const float p1 = expf(m1 - m0);
        const float w0 = gp * (1.f / (1.f + p1)), w1 = gp * (p1 / (1.f + p1));
        const int e0 = gi * 8 + i0, e1 = gi * 8 + i1;
        c.tok_e[t * 2] = e0; c.tok_e[t * 2 + 1] = e1; c.tok_w[t * 2] = w0; c.tok_w[t * 2 + 1] = w1;
        c.tok_pos[t * 2] = (int)atom_add(c.ctl + CW_CNT + l * 32 + e0, 1u); c.tok_pos[t * 2 + 1] = (int)atom_add(c.ctl + CW_CNT + l * 32 + e1, 1u);
    }
    for (size_t i = gtid; i < (size_t)NE * 512 * D; i += gsz) {
        const int k = (int)(i & 1023), rr = (int)((i >> 10) & 511), e = (int)(i >> 19);
        const int pn = rr >> 8, half = (rr >> 7) & 1, r = rr & 127;
        const float* W = (half ? c.ewu : c.ewg) + ((size_t)(l * NE + e) * D + k) * 256 + 128 * pn + r;
        c.expA[i] = f2bf(*W);
    }
    for (size_t i = gtid; i < (size_t)NE * D * 256; i += gsz) {
        const int k = (int)(i & 255), n = (int)((i >> 8) & 1023), e = (int)(i >> 18);
        c.expB[i] = f2bf(c.ewd[((size_t)(l * NE + e) * 256 + k) * D + n]);
    }
}

DEV int moe_base_tile(const unsigned* cnt, int e) { int b = 0; for (int j = 0; j < e; ++j) b += ((int)cnt[j] + 255) >> 8; return b; }

DEV void p8_gather(const Ctx& c, int l, int gtid, int gsz) {
    const unsigned* cnt = c.ctl + CW_CNT + l * 32;
    for (int i = gtid; i < T * 2 * 128; i += gsz) {
        const int ck = i & 127, tk = i >> 7; const int e = c.tok_e[tk];
        const int slot = moe_base_tile(cnt, e) * 256 + c.tok_pos[tk];
        if (ck == 0) c.tok_slot[tk] = slot;
        const u4* src = (const u4*)(c.bufB + (size_t)(tk >> 1) * D) + ck; u4* dst = (u4*)(c.xg + (size_t)slot * D) + ck;
        *dst = *src;
    }
    for (int i = gtid; i < NE * 256 * 128; i += gsz) {
        const int ck = i & 127, r = (i >> 7) & 255, e = i >> 15; const int n = (int)cnt[e], nt = (n + 255) >> 8;
        const int row = n + r;
        if (row < nt * 256) { unsigned zz = 0u;
#ifndef HOST_EMU
            asm volatile("" : "+v"(zz));
#endif
            u4 z; z.x = z.y = z.z = z.w = zz; *((u4*)(c.xg + (size_t)(moe_base_tile(cnt, e) * 256 + row) * D) + ck) = z; }
    }
}

DEV void p11_ln2(const Ctx& c, int l, int gtid, int gsz) {
    for (int t = gtid; t < T; t += gsz) {
        float* row = c.out + (size_t)t * D;
        const bf16_t* y0 = c.xg + (size_t)c.tok_slot[t * 2] * D; const bf16_t* y1 = c.xg + (size_t)c.tok_slot[t * 2 + 1] * D;
        const float w0 = c.tok_w[t * 2], w1 = c.tok_w[t * 2 + 1];
        float s = 0.f;
        for (int k = 0; k < D; ++k) { const float v = ALPHA * row[k] + (w0 * bf2f(y0[k]) + w1 * bf2f(y1[k])); row[k] = v; s += v; }
        const float mu = s * (1.f / D); float v2 = 0.f;
        for (int k = 0; k < D; ++k) { const float dd = row[k] - mu; v2 += dd * dd; }
        const float rs = 1.f / sqrtf(v2 * (1.f / D) + LN_EPS);
        for (int k = 0; k < D; ++k) { const float h = (row[k] - mu) * rs * c.ln2g[l * D + k] + c.ln2b[l * D + k]; row[k] = h; c.bufA[(size_t)t * D + k] = f2bf(h); }
    }
}

#ifndef HOST_EMU
namespace pg8 {
#define PG8_LAS __attribute__((address_space(3)))
typedef short bf16x8 __attribute__((ext_vector_type(8)));
typedef float f32x4 __attribute__((ext_vector_type(4)));
typedef unsigned u32x4 __attribute__((ext_vector_type(4)));
typedef unsigned u32x2 __attribute__((ext_vector_type(2)));
constexpr int BM = 256, BK = 64, HALF = 128, HTB = HALF * BK * 2, STAGE_BYTES = 8 * HTB, NXCD = 8, WGM = 8;

__host__ __device__ __forceinline__ int lds_byte(int r, int c) { const int st = (r >> 4) * 2 + (c >> 5), rr = r & 15, cc = c & 31, ob = rr * 64 + cc * 2; return st * 1024 + (ob ^ (((ob >> 9) & 1) << 5)); }
__host__ __device__ __forceinline__ void stage_rc(int b, int& R, int& C) { const int st = b / 1024, sb = b % 1024, swz = sb ^ (((sb >> 9) & 1) << 5); R = (st >> 1) * 16 + swz / 64; C = (st & 1) * 32 + (swz % 64) / 2; }

struct Unit { int pm, pn, pa, pb, aux; };
struct Gemm { const bf16_t* A; const bf16_t* Bt; int K; };

__device__ __forceinline__ void tile_of(int wgid, int nM, int nN, int& pm, int& pn) {
    const int nwg = nM * nN; { const int q = nwg / NXCD, r = nwg % NXCD, xcd = wgid % NXCD, off = wgid / NXCD; wgid = (xcd < r ? xcd * (q + 1) : r * (q + 1) + (xcd - r) * q) + off; }
    const int nig = WGM * nN, gid = wgid / nig, fm = gid * WGM, gsz = (nM - fm) < WGM ? (nM - fm) : WGM;
    pm = fm + ((wgid % nig) % gsz); pn = (wgid % nig) / gsz;
}
struct SchedGrid {
    int nM, nN, G, c;
    __device__ __forceinline__ bool next(int i, Unit& u) const { const long L = (long)i * G + c; if (L >= (long)nM * nN) return false; tile_of((int)L, nM, nN, u.pm, u.pn); u.pa = u.pm; u.pb = u.pn; u.aux = 0; return true; }
};
struct SchedBP {
    int nM, nN, G, c;
    __device__ __forceinline__ bool next(int i, Unit& u) const { const long L = (long)(i >> 2) * G + c; if (L >= (long)nM * nN) return false; tile_of((int)L, nM, nN, u.pm, u.pn);
        const int b = i & 3; u.aux = b; u.pa = b * nM + u.pm; u.pb = b * nN + u.pn; return true; }
};
struct SchedMoE {
    const unsigned* cnt; int npn, G, c;
    __device__ __forceinline__ bool next(int i, Unit& u) const {
        const long L = (long)i * G + c; const int rt = (int)(L / npn), pn = (int)(L % npn);
        int e = -1, base = 0;
        for (int j = 0; j < NE; ++j) { const int nt = ((int)cnt[j] + 255) >> 8; if (e < 0 && rt < base + nt) e = j; base += nt; }
        if (e < 0) return false;
        u.pm = rt; u.pa = rt; u.pn = pn; u.pb = e * npn + pn; u.aux = e; return true;
    }
};

constexpr int ULIST_OFF = STAGE_BYTES, ULIST_MAX = 32;
struct SchedLds {
    const PG8_LAS int* ul;
    __device__ __forceinline__ bool next(int i, Unit& u) const {
        if (i >= ULIST_MAX) return false;
        const PG8_LAS int* p = ul + i * 8;
        const int ok = __builtin_amdgcn_readfirstlane(p[0]); if (!ok) return false;
        u.pm = __builtin_amdgcn_readfirstlane(p[1]); u.pn = __builtin_amdgcn_readfirstlane(p[2]); u.pa = __builtin_amdgcn_readfirstlane(p[3]); u.pb = __builtin_amdgcn_readfirstlane(p[4]); u.aux = __builtin_amdgcn_readfirstlane(p[5]);
        return true;
    }
};
template <class Sched> __device__ __forceinline__ SchedLds build_units(PG8_LAS unsigned char* lds, const Sched& S) {
    PG8_LAS int* ul = (PG8_LAS int*)(lds + ULIST_OFF);
    __syncthreads();
    int tx = threadIdx.x; asm volatile("" : "+v"(tx));
    if (tx < ULIST_MAX) { Unit u; u.pm = u.pn = u.pa = u.pb = u.aux = 0; const bool ok = S.next(tx, u); PG8_LAS int* p = ul + tx * 8; p[0] = ok ? 1 : 0; p[1] = u.pm; p[2] = u.pn; p[3] = u.pa; p[4] = u.pb; p[5] = u.aux; }
    __syncthreads();
    SchedLds r; r.ul = ul; return r;
}

__device__ __forceinline__ unsigned cvt_pk_bf16(float lo, float hi) { unsigned r; asm volatile("v_cvt_pk_bf16_f32 %0, %1, %2" : "=v"(r) : "v"(lo), "v"(hi)); return r; }
__device__ __forceinline__ float bflo(unsigned w) { return __builtin_bit_cast(float, w << 16); }
__device__ __forceinline__ float bfhi(unsigned w) { return __builtin_bit_cast(float, w & 0xffff0000u); }
__device__ __forceinline__ float sigm_fast(float x) { return 1.f / (1.f + __expf(-x)); }

#define PG8_EPI_ROWS(...) _Pragma("unroll") for (int ai = 0; ai < 2; ++ai) _Pragma("unroll") for (int m = 0; m < 4; ++m) { const int row = u.pm * BM + ai * HALF + wr * 64 + m * 16 + fr; const int colb = wc * 32 + 4 * fq; \
        __VA_ARGS__ asm volatile("" ::: "memory"); }
#define PG8_FRAGS(...) _Pragma("unroll") for (int bj = 0; bj < 2; ++bj) _Pragma("unroll") for (int n = 0; n < 2; ++n) { const int fo = bj * HALF + n * 16; const f32x4 a = acc[ai][bj][m][n]; __VA_ARGS__ }

struct EpiZ {
    bf16_t* zmix; bf16_t* zgate;
    __device__ __forceinline__ void operator()(const f32x4 (&acc)[2][2][4][2], const Unit& u, int wr, int wc, int fr, int fq) const {
        if (u.pn < NMIX / 256) { PG8_EPI_ROWS( bf16_t* p = zmix + ((unsigned)row * (unsigned)NMIX + (unsigned)(u.pn * BM + colb));
            PG8_FRAGS( u32x2 w; w.x = cvt_pk_bf16(a[0], a[1]); w.y = cvt_pk_bf16(a[2], a[3]); *(u32x2*)(p + fo) = w; ) ) }
        else { PG8_EPI_ROWS( bf16_t* p = zgate + ((unsigned)row * (unsigned)NGATE + (unsigned)(u.pn * BM - NMIX + colb));
            PG8_FRAGS( u32x2 w; w.x = cvt_pk_bf16(sigm_fast(a[0]), sigm_fast(a[1])); w.y = cvt_pk_bf16(sigm_fast(a[2]), sigm_fast(a[3])); *(u32x2*)(p + fo) = w; ) ) }
    }
};
struct EpiBP {
    const bf16_t* zgate; float* part; bf16_t* merged;
    __device__ __forceinline__ void operator()(const f32x4 (&acc)[2][2][4][2], const Unit& u, int wr, int wc, int fr, int fq) const {
        const int b = u.aux;
        PG8_EPI_ROWS( const unsigned eo = (unsigned)row * (unsigned)D + (unsigned)(u.pn * BM + colb);
            const bf16_t* gp = zgate + ((unsigned)row * (unsigned)NGATE + (unsigned)(b * D + u.pn * BM + colb)); float* pp = part + eo; bf16_t* mp = merged + eo;
            PG8_FRAGS( const u32x2 g = *(const u32x2*)(gp + fo);
                f32x4 v; v[0] = bflo(g.x) * a[0]; v[1] = bfhi(g.x) * a[1]; v[2] = bflo(g.y) * a[2]; v[3] = bfhi(g.y) * a[3];
                if (b > 0) v += *(const f32x4*)(pp + fo);
                if (b < 3) *(f32x4*)(pp + fo) = v; else { u32x2 w; w.x = cvt_pk_bf16(v[0], v[1]); w.y = cvt_pk_bf16(v[2], v[3]); *(u32x2*)(mp + fo) = w; } ) )
    }
};
struct EpiRes {
    float* out;
    __device__ __forceinline__ void operator()(const f32x4 (&acc)[2][2][4][2], const Unit& u, int wr, int wc, int fr, int fq) const {
        PG8_EPI_ROWS( float* pp = out + ((unsigned)row * (unsigned)D + (unsigned)(u.pn * BM + colb));
            PG8_FRAGS( const f32x4 h = *(const f32x4*)(pp + fo); *(f32x4*)(pp + fo) = h * ALPHA + a; ) )
    }
};
struct EpiHid {
    bf16_t* hid;
    __device__ __forceinline__ void operator()(const f32x4 (&acc)[2][2][4][2], const Unit& u, int wr, int wc, int fr, int fq) const {
        PG8_EPI_ROWS( bf16_t* p = hid + ((unsigned)row * 256u + (unsigned)(u.pn * 128 + colb));
            _Pragma("unroll") for (int n = 0; n < 2; ++n) { const f32x4 g = acc[ai][0][m][n]; const f32x4 up = acc[ai][1][m][n];
                u32x2 w; w.x = cvt_pk_bf16(g[0] * sigm_fast(g[0]) * up[0], g[1] * sigm_fast(g[1]) * up[1]); w.y = cvt_pk_bf16(g[2] * sigm_fast(g[2]) * up[2], g[3] * sigm_fast(g[3]) * up[3]);
                *(u32x2*)(p + n * 16) = w; } )
    }
};
struct EpiY {
    bf16_t* y;
    __device__ __forceinline__ void operator()(const f32x4 (&acc)[2][2][4][2], const Unit& u, int wr, int wc, int fr, int fq) const {
        PG8_EPI_ROWS( bf16_t* p = y + ((unsigned)row * (unsigned)D + (unsigned)(u.pn * BM + colb));
            PG8_FRAGS( u32x2 w; w.x = cvt_pk_bf16(a[0], a[1]); w.y = cvt_pk_bf16(a[2], a[3]); *(u32x2*)(p + fo) = w; ) )
    }
};

template <class Epi, class Sched>
__device__ __forceinline__ void gemm_phase(PG8_LAS unsigned char* lds, const Gemm g, const Sched& S, const Epi& E) {
    int tid_ = threadIdx.x; asm volatile("" : "+v"(tid_)); const int tid = tid_, wid = __builtin_amdgcn_readfirstlane(tid >> 6), lane = tid & 63, wr = wid >> 2, wc = wid & 3, fr = lane & 15, fq = lane >> 4;
    const int K = g.K, nt = K / BK;
    unsigned voffA[2];
#pragma unroll
    for (int i = 0; i < 2; ++i) { int R, C; stage_rc(tid * 16 + i * 8192, R, C); voffA[i] = (unsigned)(R * K + C) * 2u; }
    const size_t kstep = (size_t)(BK * 2);
    const size_t hstep = (size_t)HALF * K * 2;
    const size_t tstep = 2 * hstep;
    const unsigned ldsw = (unsigned)wid * 1024u;
    const int aoff = lds_byte(wr * 64 + fr, fq * 8), boff = lds_byte(wc * 32 + fr, fq * 8);
#define PG8_SA(b, h) (((b) * 2 + (h)) * HTB)
#define PG8_SB(b, h) ((4 + (b) * 2 + (h)) * HTB)
#define PG8_STAGE(bufoff, gbase) do { _Pragma("unroll") for (int _i = 0; _i < 2; ++_i) \
        __builtin_amdgcn_global_load_lds((const unsigned*)((const char*)(gbase) + voffA[_i]), (PG8_LAS unsigned*)(lds + (bufoff) + ldsw + _i * 8192), 16, 0, 0); } while (0)
#define PG8_LDA(dst, b, h) do { _Pragma("unroll") for (int m = 0; m < 4; ++m) _Pragma("unroll") for (int k = 0; k < 2; ++k) dst[m][k] = *(const PG8_LAS bf16x8*)(lds + PG8_SA(b, h) + aoff + m * 2048 + k * 1024); } while (0)
#define PG8_LDB(dst, b, h) do { _Pragma("unroll") for (int n = 0; n < 2; ++n) _Pragma("unroll") for (int k = 0; k < 2; ++k) dst[n][k] = *(const PG8_LAS bf16x8*)(lds + PG8_SB(b, h) + boff + n * 2048 + k * 1024); } while (0)
#define PG8_MMA(ai, bj, At, Bt) do { __builtin_amdgcn_s_setprio(1); _Pragma("unroll") for (int m = 0; m < 4; ++m) _Pragma("unroll") for (int n = 0; n < 2; ++n) _Pragma("unroll") for (int k = 0; k < 2; ++k) \
        acc[ai][bj][m][n] = __builtin_amdgcn_mfma_f32_16x16x32_bf16(Bt[n][k], At[m][k], acc[ai][bj][m][n], 0, 0, 0); __builtin_amdgcn_s_setprio(0); } while (0)
#define PG8_WAIT_V(n) asm volatile("s_waitcnt vmcnt(" #n ")" ::: "memory")
#define PG8_WAIT_L(n) asm volatile("s_waitcnt lgkmcnt(" #n ")" ::: "memory")
#define PG8_BAR __builtin_amdgcn_s_barrier()
#define PG8_SCHED __builtin_amdgcn_sched_barrier(0)
    Unit cur, nxt; int ui = 0;
    if (!S.next(0, cur)) return;
    f32x4 acc[2][2][4][2];
#pragma unroll
    for (int a = 0; a < 2; ++a)
#pragma unroll
        for (int b = 0; b < 2; ++b)
#pragma unroll
            for (int m = 0; m < 4; ++m)
#pragma unroll
                for (int n = 0; n < 2; ++n) acc[a][b][m][n] = (f32x4){0.f, 0.f, 0.f, 0.f};
    bf16x8 At[4][2], B0[2][2], B1[2][2];
    const char* cA = (const char*)g.A + (size_t)cur.pa * tstep; const char* cB = (const char*)g.Bt + (size_t)cur.pb * tstep;
    PG8_STAGE(PG8_SB(0, 0), cB); PG8_STAGE(PG8_SB(0, 1), cB + hstep); PG8_STAGE(PG8_SA(0, 0), cA); PG8_STAGE(PG8_SA(0, 1), cA + hstep);
    if (wr == 1) PG8_BAR;
    PG8_WAIT_V(2); PG8_BAR;
    PG8_STAGE(PG8_SB(1, 0), cB + kstep); PG8_STAGE(PG8_SA(1, 0), cA + kstep); PG8_STAGE(PG8_SB(1, 1), cB + hstep + kstep);
    PG8_WAIT_V(6); PG8_BAR;
    for (;;) {
        const bool has_next = S.next(ui + 1, nxt);
        const char* nA = has_next ? (const char*)g.A + (size_t)nxt.pa * tstep : cA; const char* nB = has_next ? (const char*)g.Bt + (size_t)nxt.pb * tstep : cB;
        _Pragma("nounroll") for (int t = 0; t < nt; t += 2) {
            const bool last = (t == nt - 2);
            const char* a1 = cA + (size_t)(t + 1) * kstep;
            const char* a2 = last ? nA : cA + (size_t)(t + 2) * kstep; const char* b2 = last ? nB : cB + (size_t)(t + 2) * kstep;
            const char* a3 = a2 + kstep; const char* b3 = b2 + kstep;
            PG8_LDB(B0, 0, 0); PG8_LDB(B1, 0, 1); PG8_SCHED; PG8_LDA(At, 0, 0); PG8_STAGE(PG8_SA(1, 1), a1 + hstep);
            PG8_WAIT_V(8); PG8_WAIT_L(0); PG8_BAR; PG8_MMA(0, 0, At, B0); PG8_MMA(0, 1, At, B1); PG8_BAR; PG8_SCHED;
            PG8_LDA(At, 0, 1); PG8_STAGE(PG8_SB(0, 0), b2); PG8_STAGE(PG8_SB(0, 1), b2 + hstep); PG8_STAGE(PG8_SA(0, 0), a2);
            PG8_WAIT_V(8); PG8_WAIT_L(0); PG8_BAR; PG8_MMA(1, 0, At, B0); PG8_MMA(1, 1, At, B1); PG8_BAR; PG8_SCHED;
            PG8_LDB(B0, 1, 0); PG8_LDB(B1, 1, 1); PG8_SCHED; PG8_LDA(At, 1, 0); PG8_STAGE(PG8_SA(0, 1), a2 + hstep);
            PG8_WAIT_V(8); PG8_WAIT_L(0); PG8_BAR; PG8_MMA(0, 0, At, B0); PG8_MMA(0, 1, At, B1); PG8_BAR; PG8_SCHED;
            PG8_LDA(At, 1, 1); PG8_STAGE(PG8_SB(1, 0), b3); PG8_STAGE(PG8_SB(1, 1), b3 + hstep); PG8_STAGE(PG8_SA(1, 0), a3);
            PG8_WAIT_V(8); PG8_WAIT_L(0); PG8_BAR; PG8_MMA(1, 0, At, B0); PG8_MMA(1, 1, At, B1); PG8_BAR; PG8_SCHED;
        }
        if (wr == 0) PG8_BAR;
        E(acc, cur, wr, wc, fr, fq);
        if (!has_next) break;
#pragma unroll
        for (int a = 0; a < 2; ++a)
#pragma unroll
            for (int b = 0; b < 2; ++b)
#pragma unroll
                for (int m = 0; m < 4; ++m)
#pragma unroll
                    for (int n = 0; n < 2; ++n) acc[a][b][m][n] = (f32x4){0.f, 0.f, 0.f, 0.f};
        cur = nxt; cA = nA; cB = nB; ++ui;
        if (wr == 1) PG8_BAR;
    }
    PG8_WAIT_V(0);
    PG8_BAR;
#undef PG8_SA
#undef PG8_SB
#undef PG8_STAGE
#undef PG8_LDA
#undef PG8_LDB
#undef PG8_MMA
#undef PG8_WAIT_V
#undef PG8_WAIT_L
#undef PG8_BAR
#undef PG8_SCHED
}
}

namespace fast {
#define LAS __attribute__((address_space(3)))
typedef float f32x4 __attribute__((ext_vector_type(4)));
typedef short bf16x8 __attribute__((ext_vector_type(8)));
typedef unsigned u32x2 __attribute__((ext_vector_type(2)));
typedef unsigned u32x4 __attribute__((ext_vector_type(4)));
#define LDS_WAIT() asm volatile("s_waitcnt lgkmcnt(0)" ::: "memory")
#define VM_WAIT() asm volatile("s_waitcnt vmcnt(0)" ::: "memory")
__device__ __forceinline__ float wave_sum(float v) {
#pragma unroll
    for (int o = 1; o < 64; o <<= 1) v += __shfl_xor(v, o);
    return v;
}
using pg8::cvt_pk_bf16;
__device__ __forceinline__ void transpose_item(const float* W, int K, int N, bf16_t* WT, int k0, int n0, int drow0, LAS float* scr, int lane) {
#pragma unroll 8
    for (int i = 0; i < 32; ++i) { const int kk = 2 * i + (lane >> 5); scr[kk * 33 + (lane & 31)] = W[(size_t)(k0 + kk) * N + n0 + (lane & 31)]; }
    LDS_WAIT();
    const int cc = lane & 7;
#pragma unroll
    for (int j = 0; j < 4; ++j) { const int n = (lane >> 3) + 8 * j; const LAS float* sp = scr + (8 * cc) * 33 + n;
        u32x4 o; o.x = cvt_pk_bf16(sp[0 * 33], sp[1 * 33]); o.y = cvt_pk_bf16(sp[2 * 33], sp[3 * 33]); o.z = cvt_pk_bf16(sp[4 * 33], sp[5 * 33]); o.w = cvt_pk_bf16(sp[6 * 33], sp[7 * 33]);
        *(u32x4*)(WT + (size_t)(drow0 + n) * K + k0 + 8 * cc) = o; }
    LDS_WAIT();
}
__device__ __forceinline__ void tr_matrix_item(const float* W, int K, int N, bf16_t* WT, int it, LAS float* scr, int lane) { const int nblk = N / 32, kb = it / nblk, nb = it % nblk; transpose_item(W, K, N, WT, 64 * kb, 32 * nb, 32 * nb, scr, lane); }

__device__ __forceinline__ void p0(const Ctx& c, LAS unsigned char* lds, int G, int bx) {
    int tid = threadIdx.x; asm volatile("" : "+v"(tid));
    const int lane = tid & 63, wave = tid >> 6, gw = bx * 8 + wave, NGW = G * 8, gtid = bx * 512 + tid, gsz = G * 512;
    LAS float* scr = (LAS float*)(lds + wave * 16384);
    constexpr int I_IN = (D / 64) * (NIN / 32), I_BP = (256 / 64) * (D / 32), I_WO = (D / 64) * (D / 32), I_L = I_IN + 4 * I_BP + I_WO;
    for (int it = gw; it < 2 * I_L; it += NGW) {
        const int l = it / I_L; int r = it % I_L;
        if (r < I_IN) { tr_matrix_item(c.w_in + (size_t)l * D * NIN, D, NIN, c.w_in_t + (size_t)l * NIN * D, r, scr, lane); continue; } r -= I_IN;
        if (r < 4 * I_BP) { const int b = r / I_BP; tr_matrix_item(c.bproj + ((size_t)l * 4 + b) * 256 * D, 256, D, c.bp_t + ((size_t)l * 4 + b) * D * 256, r % I_BP, scr, lane); continue; } r -= 4 * I_BP;
        tr_matrix_item(c.wout + (size_t)l * D * D, D, D, c.wout_t + (size_t)l * D * D, r, scr, lane);
    }
    for (int i = gtid; i < 2 * 48 * D; i += gsz) {
        const int k = i & 1023, j = (i >> 10) % 48, l = i / (48 * D);
        const float w = j < 4 ? c.rgw[((size_t)l * D + k) * 4 + j] : (j < 36 ? c.rew[((size_t)l * D + k) * 32 + (j - 4)] : 0.f);
        const bf16_t hi = f2bf(w); c.wr_hi[i] = hi; c.wr_lo[i] = f2bf(w - bf2f(hi));
    }
    for (int i = gtid; i < 2 * 4 * 128 * 128; i += gsz) { const int s2 = i & 127, t = (i >> 7) & 127; c.sgw[i] = s2 <= t ? f2bf(c.sg_ws[i]) : (bf16_t)0; }
    for (int i = gtid; i < 2 * 4 * 4096; i += gsz) { const int d = i & 63, e = (i >> 6) & 63, lh = i >> 12; c.lwrT[i] = f2bf(c.lru_wr[(size_t)lh * 4096 + d * 64 + e]); c.lwiT[i] = f2bf(c.lru_wi[(size_t)lh * 4096 + d * 64 + e]); }
    for (int i = gtid; i < T * 32; i += gsz) {
        const int t = i >> 5, j = i & 31;
        const float inv = exp2f(-(float)j * (13.287712379549449f / 32.f));
        const float ang = (float)c.pos[t] * inv;
        c.ropec[i] = cosf(ang); c.ropes[i] = sinf(ang);
    }
    for (int i = gtid; i < T * D / 4; i += gsz) { const f32x4 v = ((const f32x4*)c.x)[i]; ((f32x4*)c.out)[i] = v; u32x2 w; w.x = cvt_pk_bf16(v[0], v[1]); w.y = cvt_pk_bf16(v[2], v[3]); ((u32x2*)c.bufA)[i] = w; }
}

__device__ __forceinline__ void p7(const Ctx& c, int l, LAS unsigned char* lds, int G, int bx) {
    int tid = threadIdx.x; asm volatile("" : "+v"(tid));
    const int lane = tid & 63, wave = tid >> 6, gw = bx * 8 + wave, NGW = G * 8;
    LAS float* scr = (LAS float*)(lds + wave * 16384);
    const float* gam = c.ln1g + l * D; const float* bet = c.ln1b + l * D;
    for (int grp = gw; grp < T / 16; grp += NGW) {
        const int r0 = grp * 16;
#pragma nounroll
        for (int rr = 0; rr < 16; ++rr) {
            const size_t ro = (size_t)(r0 + rr) * D;
            f32x4* xr = (f32x4*)(c.out + ro) + lane; f32x4 v[4]; float sm = 0.f;
#pragma unroll
            for (int j = 0; j < 4; ++j) { v[j] = xr[64 * j]; sm += (v[j][0] + v[j][1]) + (v[j][2] + v[j][3]); }
            const float mean = wave_sum(sm) * (1.f / D); float s2 = 0.f;
#pragma unroll
            for (int j = 0; j < 4; ++j) { v[j] = v[j] - mean; s2 += (v[j][0] * v[j][0] + v[j][1] * v[j][1]) + (v[j][2] * v[j][2] + v[j][3] * v[j][3]); }
            const float rstd = 1.f / sqrtf(wave_sum(s2) * (1.f / D) + LN_EPS);
#pragma unroll
            for (int j = 0; j < 4; ++j) {
                const f32x4 g4 = ((const f32x4*)gam)[lane + 64 * j], b4 = ((const f32x4*)bet)[lane + 64 * j];
                const f32x4 h = v[j] * rstd * g4 + b4; xr[64 * j] = h;
                u32x2 hi; hi.x = cvt_pk_bf16(h[0], h[1]); hi.y = cvt_pk_bf16(h[2], h[3]);
                const float l0 = h[0] - pg8::bflo(hi.x), l1 = h[1] - pg8::bfhi(hi.x), l2 = h[2] - pg8::bflo(hi.y), l3 = h[3] - pg8::bfhi(hi.y);
                u32x2 lo; lo.x = cvt_pk_bf16(l0, l1); lo.y = cvt_pk_bf16(l2, l3);
                ((u32x2*)(c.bufB + ro))[lane + 64 * j] = hi; ((u32x2*)(c.hlo + ro))[lane + 64 * j] = lo;
            }
        }
        VM_WAIT();
        f32x4 acc[3];
#pragma unroll
        for (int ct = 0; ct < 3; ++ct) acc[ct] = (f32x4){0.f, 0.f, 0.f, 0.f};
        const size_t ao = (size_t)(r0 + (lane & 15)) * D + 8 * (lane >> 4);
        const size_t bo = (size_t)(l * 48 + (lane & 15)) * D + 8 * (lane >> 4);
#pragma unroll 2
        for (int ks = 0; ks < 32; ++ks) {
            const bf16x8 ah = *(const bf16x8*)(c.bufB + ao + ks * 32), al = *(const bf16x8*)(c.hlo + ao + ks * 32);
#pragma unroll
            for (int ct = 0; ct < 3; ++ct) {
                const bf16x8 bh = *(const bf16x8*)(c.wr_hi + bo + (size_t)ct * 16 * D + ks * 32), bl = *(const bf16x8*)(c.wr_lo + bo + (size_t)ct * 16 * D + ks * 32);
                acc[ct] = __builtin_amdgcn_mfma_f32_16x16x32_bf16(ah, bh, acc[ct], 0, 0, 0);
                acc[ct] = __builtin_amdgcn_mfma_f32_16x16x32_bf16(al, bh, acc[ct], 0, 0, 0);
                acc[ct] = __builtin_amdgcn_mfma_f32_16x16x32_bf16(ah, bl, acc[ct], 0, 0, 0);
            }
        }
#pragma unroll
        for (int ct = 0; ct < 3; ++ct)
#pragma unroll
            for (int r = 0; r < 4; ++r) scr[(4 * (lane >> 4) + r) * 48 + ct * 16 + (lane & 15)] = acc[ct][r];
        LDS_WAIT();
        if (lane < 16) {
            const int t = r0 + lane; float lg[36];
#pragma unroll
            for (int j = 0; j < 36; ++j) lg[j] = scr[lane * 48 + j] + (j < 4 ? c.rgb[l * 4 + j] : c.reb[l * 32 + (j - 4)]);
            int gi = 0; float gm = lg[0];
#pragma unroll
            for (int j = 1; j < 4; ++j) if (lg[j] > gm) { gm = lg[j]; gi = j; }
            float gs = 0.f;
#pragma unroll
            for (int j = 0; j < 4; ++j) gs += expf(lg[j] - gm);
            const float gp = 1.f / gs;
            float el[8];
#pragma unroll
            for (int j = 0; j < 8; ++j) { float v = 0.f;
#pragma unroll
                for (int g2 = 0; g2 < 4; ++g2) if (g2 == gi) v = lg[4 + g2 * 8 + j];
                el[j] = v; }
            int i0 = 0; float m0 = el[0];
#pragma unroll
            for (int j = 1; j < 8; ++j) if (el[j] > m0) { m0 = el[j]; i0 = j; }
            int i1 = -1; float m1 = -3.0e38f;
#pragma unroll
            for (int j = 0; j < 8; ++j) if (j != i0 && el[j] > m1) { m1 = el[j]; i1 = j; }
            const float p1 = expf(m1 - m0);
            const float w0 = gp * (1.f / (1.f + p1)), w1 = gp * (p1 / (1.f + p1));
            const int e0 = gi * 8 + i0, e1 = gi * 8 + i1;
            c.tok_e[t * 2] = e0; c.tok_e[t * 2 + 1] = e1; c.tok_w[t * 2] = w0; c.tok_w[t * 2 + 1] = w1;
            c.tok_pos[t * 2] = (int)atomicAdd(c.ctl + CW_CNT + l * 32 + e0, 1u); c.tok_pos[t * 2 + 1] = (int)atomicAdd(c.ctl + CW_CNT + l * 32 + e1, 1u);
        }
        LDS_WAIT();
    }
    for (int it = gw; it < NE * 384; it += NGW) {
        const int e = it / 384, r = it % 384;
        if (r < 256) { const int half = r >> 7, q = r & 127, kb = q >> 3, nb = q & 7, n0 = 32 * nb;
            transpose_item((half ? c.ewu : c.ewg) + (size_t)(l * NE + e) * D * 256, D, 256, c.expA + (size_t)e * 512 * D, 64 * kb, n0, (n0 >> 7) * 256 + half * 128 + (n0 & 127), scr, lane); }
        else { const int q = r - 256, kb = q >> 5, nb = q & 31;
            transpose_item(c.ewd + (size_t)(l * NE + e) * 256 * D, 256, D, c.expB + (size_t)e * D * 256, 64 * kb, 32 * nb, 32 * nb, scr, lane); }
    }
}

__device__ __forceinline__ void p8(const Ctx& c, int l, LAS unsigned char* lds, int G, int bx) {
    int tid = threadIdx.x; asm volatile("" : "+v"(tid));
    const int gtid = bx * 512 + tid, gsz = G * 512;
    const unsigned* cnt = c.ctl + CW_CNT + l * 32;
    LAS int* sb = (LAS int*)lds;
    __syncthreads();
    if (tid < NE) { sb[tid] = moe_base_tile(cnt, tid) * 256; sb[32 + tid] = (int)cnt[tid]; }
    __syncthreads();
    for (int i = gtid; i < T * 2 * 128; i += gsz) {
        const int ck = i & 127, tk = i >> 7; const int e = c.tok_e[tk];
        const int slot = sb[e] + c.tok_pos[tk];
        if (ck == 0) c.tok_slot[tk] = slot;
        *((u32x4*)(c.xg + (size_t)slot * D) + ck) = *((const u32x4*)(c.bufB + (size_t)(tk >> 1) * D) + ck);
    }
    for (int i = gtid; i < NE * 256 * 128; i += gsz) {
        const int ck = i & 127, r = (i >> 7) & 255, e = i >> 15; const int n = sb[32 + e], nt = (n + 255) >> 8, row = n + r;
        if (row < nt * 256) { unsigned zz = 0u; asm volatile("" : "+v"(zz)); u32x4 z; z.x = zz; z.y = zz; z.z = zz; z.w = zz; *((u32x4*)(c.xg + (size_t)(sb[e] + row) * D) + ck) = z; }
    }
    __syncthreads();
}

__device__ __forceinline__ void p11(const Ctx& c, int l, int G, int bx) {
    int tid = threadIdx.x; asm volatile("" : "+v"(tid));
    const int lane = tid & 63, wave = tid >> 6, gw = bx * 8 + wave, NGW = G * 8;
    const float* gam = c.ln2g + l * D; const float* bet = c.ln2b + l * D;
    for (int row = gw; row < T; row += NGW) {
        const size_t ro = (size_t)row * D;
        const int s0 = c.tok_slot[row * 2], s1 = c.tok_slot[row * 2 + 1]; const float w0 = c.tok_w[row * 2], w1 = c.tok_w[row * 2 + 1];
        f32x4* xr = (f32x4*)(c.out + ro) + lane; const u32x2* y0 = (const u32x2*)(c.xg + (size_t)s0 * D) + lane; const u32x2* y1 = (const u32x2*)(c.xg + (size_t)s1 * D) + lane;
        f32x4 v[4]; float sm = 0.f;
#pragma unroll
        for (int j = 0; j < 4; ++j) { const f32x4 h = xr[64 * j]; const u32x2 a = y0[64 * j], b = y1[64 * j];
            f32x4 f; f[0] = w0 * pg8::bflo(a.x) + w1 * pg8::bflo(b.x); f[1] = w0 * pg8::bfhi(a.x) + w1 * pg8::bfhi(b.x); f[2] = w0 * pg8::bflo(a.y) + w1 * pg8::bflo(b.y); f[3] = w0 * pg8::bfhi(a.y) + w1 * pg8::bfhi(b.y);
            v[j] = h * ALPHA + f; sm += (v[j][0] + v[j][1]) + (v[j][2] + v[j][3]); }
        const float mean = wave_sum(sm) * (1.f / D); float s2 = 0.f;
#pragma unroll
        for (int j = 0; j < 4; ++j) { v[j] = v[j] - mean; s2 += (v[j][0] * v[j][0] + v[j][1] * v[j][1]) + (v[j][2] * v[j][2] + v[j][3] * v[j][3]); }
        const float rstd = 1.f / sqrtf(wave_sum(s2) * (1.f / D) + LN_EPS);
#pragma unroll
        for (int j = 0; j < 4; ++j) {
            const f32x4 g4 = ((const f32x4*)gam)[lane + 64 * j], b4 = ((const f32x4*)bet)[lane + 64 * j];
            const f32x4 h = v[j] * rstd * g4 + b4; xr[64 * j] = h;
            u32x2 hb; hb.x = cvt_pk_bf16(h[0], h[1]); hb.y = cvt_pk_bf16(h[2], h[3]); ((u32x2*)(c.bufA + ro))[lane + 64 * j] = hb;
        }
    }
}
}

namespace mix {
using fast::f32x4; using fast::bf16x8; using fast::u32x4; using fast::u32x2;
constexpr int PK = 72, PM = 136;
__device__ __forceinline__ float bfel(const u32x4& v, int j) { const unsigned w = v[j >> 1]; return (j & 1) ? pg8::bfhi(w) : pg8::bflo(w); }
__device__ __forceinline__ bf16x8 frag(const LAS bf16_t* base, int row, int pitch, int k0) { return *(const LAS bf16x8*)(base + row * pitch + k0); }
__device__ __forceinline__ u32x4 pack8(const float (&v)[8]) { u32x4 o; o.x = pg8::cvt_pk_bf16(v[0], v[1]); o.y = pg8::cvt_pk_bf16(v[2], v[3]); o.z = pg8::cvt_pk_bf16(v[4], v[5]); o.w = pg8::cvt_pk_bf16(v[6], v[7]); return o; }
#define MFMA16(a, b, c) __builtin_amdgcn_mfma_f32_16x16x32_bf16(a, b, c, 0, 0, 0)

__device__ __forceinline__ void rope8(const Ctx& c, const bf16_t* p, int t, int d0, float sc, float (&lo)[8], float (&hi)[8]) {
    const u32x4 a = *(const u32x4*)p, b = *(const u32x4*)(p + 32);
    const f32x4 c0 = *(const f32x4*)(c.ropec + t * 32 + d0), c1 = *(const f32x4*)(c.ropec + t * 32 + d0 + 4), s0 = *(const f32x4*)(c.ropes + t * 32 + d0), s1 = *(const f32x4*)(c.ropes + t * 32 + d0 + 4);
#pragma unroll
    for (int j = 0; j < 8; ++j) { const float x1 = bfel(a, j), x2 = bfel(b, j), cs = j < 4 ? c0[j & 3] : c1[j & 3], sn = j < 4 ? s0[j & 3] : s1[j & 3];
        lo[j] = (x1 * cs - x2 * sn) * sc; hi[j] = (x2 * cs + x1 * sn) * sc; }
}
__device__ __forceinline__ void load_vT(const Ctx& c, int t0, int hd, LAS bf16_t* VT, int tid) {
#pragma unroll
    for (int i = 0; i < 2; ++i) { const int idx = tid * 2 + i, m = idx >> 3, e0 = (idx & 7) * 8;
        const u32x4 v = *(const u32x4*)(c.zmix + (size_t)(t0 + m) * NMIX + C_RV + hd * 64 + e0);
#pragma unroll
        for (int j = 0; j < 8; ++j) VT[(e0 + j) * PM + m] = (bf16_t)((j & 1) ? (v[j >> 1] >> 16) : (v[j >> 1] & 0xffffu)); }
}

__device__ __forceinline__ void ret_kv_item(const Ctx& c, int gc, int hd, LAS unsigned char* lds, int tid) {
    LAS bf16_t* KT = (LAS bf16_t*)lds; LAS bf16_t* VT = KT + 64 * PM;
    const int t0 = gc * 128; const float lg = ret_lg(hd);
    { const int m = tid >> 2, d0 = (tid & 3) * 8, t = t0 + m; float lo[8], hi[8];
      rope8(c, c.zmix + (size_t)t * NMIX + C_RK + hd * 64 + d0, t, d0, 0.125f * expf((float)(127 - m) * lg), lo, hi);
#pragma unroll
      for (int j = 0; j < 8; ++j) { KT[(d0 + j) * PM + m] = f2bf(lo[j]); KT[(d0 + 32 + j) * PM + m] = f2bf(hi[j]); } }
    load_vT(c, t0, hd, VT, tid);
    __syncthreads();
    const int w = tid >> 6, lane = tid & 63, q = lane >> 4, lr = lane & 15, it = w >> 1;
#pragma unroll
    for (int jj = 0; jj < 2; ++jj) { const int jn = (w & 1) * 2 + jj; f32x4 acc = (f32x4){0.f, 0.f, 0.f, 0.f};
#pragma unroll
        for (int ks = 0; ks < 4; ++ks) acc = MFMA16(frag(KT, 16 * it + lr, PM, 32 * ks + 8 * q), frag(VT, 16 * jn + lr, PM, 32 * ks + 8 * q), acc);
#pragma unroll
        for (int r = 0; r < 4; ++r) c.rstate[((size_t)(gc * 4 + hd) * 64 + 16 * it + 4 * q + r) * 64 + 16 * jn + lr] = acc[r]; }
    __syncthreads();
}

__device__ __forceinline__ void ret_out_item(const Ctx& c, int l, int gc, int hd, LAS unsigned char* lds, int tid) {
    LAS bf16_t* Q = (LAS bf16_t*)lds; LAS bf16_t* K = Q + 128 * PK; LAS bf16_t* VT = K + 128 * PK; LAS bf16_t* PT = VT + 64 * PM; LAS bf16_t* P = PT + 64 * PK;
    const int t0 = gc * 128; const float lg = ret_lg(hd);
    { const int m = tid >> 2, d0 = (tid & 3) * 8, t = t0 + m; float lo[8], hi[8];
      rope8(c, c.zmix + (size_t)t * NMIX + C_RQ + hd * 64 + d0, t, d0, 1.f, lo, hi);
      *(LAS u32x4*)(Q + m * PK + d0) = pack8(lo); *(LAS u32x4*)(Q + m * PK + d0 + 32) = pack8(hi);
      rope8(c, c.zmix + (size_t)t * NMIX + C_RK + hd * 64 + d0, t, d0, 0.125f, lo, hi);
      *(LAS u32x4*)(K + m * PK + d0) = pack8(lo); *(LAS u32x4*)(K + m * PK + d0 + 32) = pack8(hi); }
    load_vT(c, t0, hd, VT, tid);
    { const int idx = tid * 8, d = idx >> 6, e0 = idx & 63; const float* pp = c.rstate + (size_t)(gc * 4 + hd) * 4096 + idx;
      const f32x4 a = *(const f32x4*)pp, b = *(const f32x4*)(pp + 4);
#pragma unroll
      for (int j = 0; j < 8; ++j) PT[(e0 + j) * PK + d] = f2bf(j < 4 ? a[j & 3] : b[j & 3]); }
    __syncthreads();
    const int w = tid >> 6, lane = tid & 63, q = lane >> 4, lr = lane & 15;
    bf16x8 qf[2];
#pragma unroll
    for (int ks = 0; ks < 2; ++ks) qf[ks] = frag(Q, 16 * w + lr, PK, 32 * ks + 8 * q);
    for (int mt = 0; mt < 8; ++mt) {
        if (mt <= w) { f32x4 acc = (f32x4){0.f, 0.f, 0.f, 0.f};
#pragma unroll
            for (int ks = 0; ks < 2; ++ks) acc = MFMA16(qf[ks], frag(K, 16 * mt + lr, PK, 32 * ks + 8 * q), acc);
#pragma unroll
            for (int r = 0; r < 4; ++r) { const int n = 16 * w + 4 * q + r, m = 16 * mt + lr; P[n * PM + m] = n >= m ? f2bf(acc[r] * expf((float)(n - m) * lg)) : (bf16_t)0; } }
        else {
#pragma unroll
            for (int r = 0; r < 4; ++r) P[(16 * w + 4 * q + r) * PM + 16 * mt + lr] = (bf16_t)0; }
    }
    f32x4 o[4];
#pragma unroll
    for (int jn = 0; jn < 4; ++jn) { o[jn] = (f32x4){0.f, 0.f, 0.f, 0.f};
#pragma unroll
        for (int ks = 0; ks < 2; ++ks) o[jn] = MFMA16(qf[ks], frag(PT, 16 * jn + lr, PK, 32 * ks + 8 * q), o[jn]); }
#pragma unroll
    for (int r = 0; r < 4; ++r) { const float qd = expf((float)(16 * w + 4 * q + r + 1) * lg);
#pragma unroll
        for (int jn = 0; jn < 4; ++jn) o[jn][r] *= qd; }
#pragma unroll
    for (int ks = 0; ks < 4; ++ks) { const bf16x8 a = frag(P, 16 * w + lr, PM, 32 * ks + 8 * q);
#pragma unroll
        for (int jn = 0; jn < 4; ++jn) o[jn] = MFMA16(a, frag(VT, 16 * jn + lr, PM, 32 * ks + 8 * q), o[jn]); }
    bf16_t* br3 = c.bufB + (size_t)3 * T * 256;
#pragma unroll
    for (int r = 0; r < 4; ++r) {
        float sm = (o[0][r] + o[1][r]) + (o[2][r] + o[3][r]);
#pragma unroll
        for (int x = 1; x < 16; x <<= 1) sm += __shfl_xor(sm, x);
        const float mu = sm * (1.f / 64.f); float v2 = 0.f;
#pragma unroll
        for (int jn = 0; jn < 4; ++jn) { const float dd = o[jn][r] - mu; v2 += dd * dd; }
#pragma unroll
        for (int x = 1; x < 16; x <<= 1) v2 += __shfl_xor(v2, x);
        const float rs = 1.f / sqrtf(v2 * (1.f / 64.f) + LN_EPS); const int t = t0 + 16 * w + 4 * q + r;
#pragma unroll
        for (int jn = 0; jn < 4; ++jn) { const int e = hd * 64 + 16 * jn + lr; const float g = bf2f(c.zmix[(size_t)t * NMIX + C_RG + e]);
            br3[(size_t)t * 256 + e] = f2bf(silu_(g) * ((o[jn][r] - mu) * rs * c.ret_ng[l * 256 + e])); }
    }
    __syncthreads();
}

__device__ __forceinline__ void sg_item(const Ctx& c, int l, int gc, int g, LAS unsigned char* lds, int tid) {
    LAS bf16_t* VN = (LAS bf16_t*)lds;
    const int t0 = gc * 128;
    { const int s2 = tid >> 2, d0 = (tid & 3) * 16; const bf16_t* p = c.zmix + (size_t)(t0 + s2) * NMIX + C_SGV + g * 64 + d0;
      const u32x4 a = *(const u32x4*)p, b = *(const u32x4*)(p + 8); float v[16]; float sm = 0.f;
#pragma unroll
      for (int j = 0; j < 16; ++j) { v[j] = gelu_(j < 8 ? bfel(a, j & 7) : bfel(b, j & 7)); sm += v[j]; }
      sm += __shfl_xor(sm, 1); sm += __shfl_xor(sm, 2);
      const float mu = sm * (1.f / 64.f); float v2 = 0.f;
#pragma unroll
      for (int j = 0; j < 16; ++j) { v[j] -= mu; v2 += v[j] * v[j]; }
      v2 += __shfl_xor(v2, 1); v2 += __shfl_xor(v2, 2);
      const float rs = 1.f / sqrtf(v2 * (1.f / 64.f) + LN_EPS);
#pragma unroll
      for (int j = 0; j < 16; ++j) VN[(d0 + j) * PM + s2] = f2bf(v[j] * rs * c.sg_ng[l * 256 + g * 64 + d0 + j]); }
    __syncthreads();
    const int w = tid >> 6, lane = tid & 63, q = lane >> 4, lr = lane & 15;
    f32x4 acc[4];
#pragma unroll
    for (int jn = 0; jn < 4; ++jn) acc[jn] = (f32x4){0.f, 0.f, 0.f, 0.f};
    const bf16_t* wrow = c.sgw + ((size_t)(l * 4 + g) * 128 + 16 * w + lr) * 128 + 8 * q;
    for (int ks = 0; ks <= (w >> 1); ++ks) { const bf16x8 a = *(const bf16x8*)(wrow + 32 * ks);
#pragma unroll
        for (int jn = 0; jn < 4; ++jn) acc[jn] = MFMA16(a, frag(VN, 16 * jn + lr, PM, 32 * ks + 8 * q), acc[jn]); }
    bf16_t* br2 = c.bufB + (size_t)2 * T * 256;
#pragma unroll
    for (int r = 0; r < 4; ++r) { const int tt = 16 * w + 4 * q + r, t = t0 + tt; const float bs = c.sg_bs[(l * 4 + g) * 128 + tt];
#pragma unroll
        for (int jn = 0; jn < 4; ++jn) { const int ch = g * 64 + 16 * jn + lr; br2[(size_t)t * 256 + ch] = f2bf(gelu_(bf2f(c.zmix[(size_t)t * NMIX + C_SGU + ch])) * (acc[jn][r] + bs)); } }
    __syncthreads();
}

__device__ __forceinline__ void lru_item(const Ctx& c, int l, int gc, int hd, bool final, LAS unsigned char* lds, int tid) {
    LAS float* XC = (LAS float*)lds;
    LAS bf16_t* XB = (LAS bf16_t*)(lds + 33280);
    LAS float* AA = (LAS float*)(lds + 33280 + 18432);
    LAS float* UU = AA + 128 * 64;
    LAS float* TOT = UU + 128 * 64;
    const int t0 = gc * 128;
#pragma unroll
    for (int i = 0; i < 2; ++i) { const int idx = tid * 2 + i, tt = idx >> 3, ch0 = (idx & 7) * 8, t = t0 + tt, sq = t % S, ch = hd * 64 + ch0; float acc[8];
#pragma unroll
        for (int j = 0; j < 8; ++j) acc[j] = c.lru_cb[l * 256 + ch + j];
#pragma unroll
        for (int k = 0; k < 4; ++k) if (sq - 3 + k >= 0) { const u32x4 x = *(const u32x4*)(c.zmix + (size_t)(t - 3 + k) * NMIX + C_LRX + ch);
#pragma unroll
            for (int j = 0; j < 8; ++j) acc[j] += c.lru_cw[(l * 4 + k) * 256 + ch + j] * bfel(x, j); }
#pragma unroll
        for (int j = 0; j < 8; ++j) XC[tt * 65 + ch0 + j] = acc[j];
        *(LAS u32x4*)(XB + tt * PK + ch0) = pack8(acc); }
    __syncthreads();
    const int w = tid >> 6, lane = tid & 63, q = lane >> 4, lr = lane & 15;
    { bf16x8 af[2];
#pragma unroll
      for (int ks = 0; ks < 2; ++ks) af[ks] = frag(XB, 16 * w + lr, PK, 32 * ks + 8 * q);
#pragma unroll
      for (int jn = 0; jn < 4; ++jn) { const int e = 16 * jn + lr, ch = hd * 64 + e; f32x4 ar = (f32x4){0.f, 0.f, 0.f, 0.f}, ai = ar;
          const bf16_t* wr = c.lwrT + ((size_t)(l * 4 + hd) * 64 + e) * 64 + 8 * q; const bf16_t* wi = c.lwiT + ((size_t)(l * 4 + hd) * 64 + e) * 64 + 8 * q;
#pragma unroll
          for (int ks = 0; ks < 2; ++ks) { ar = MFMA16(af[ks], *(const bf16x8*)(wr + 32 * ks), ar); ai = MFMA16(af[ks], *(const bf16x8*)(wi + 32 * ks), ai); }
          const float sp = softplus_(-c.lru_lam[l * 256 + ch]), brr = c.lru_br[l * 256 + ch], bii = c.lru_bi[l * 256 + ch];
#pragma unroll
          for (int r = 0; r < 4; ++r) { const int tt = 16 * w + 4 * q + r; const float rg = sigm(ar[r] + brr), ig = sigm(ai[r] + bii), la = -8.f * rg * sp;
              AA[tt * 64 + e] = expf(la); UU[tt * 64 + e] = sqrtf(-expm1f(2.f * la)) * (ig * XC[tt * 65 + e]); } } }
    __syncthreads();
    { float A = 1.f, H = 0.f;
#pragma unroll 4
      for (int k = 0; k < 16; ++k) { const float a = AA[(16 * w + k) * 64 + lane], u = UU[(16 * w + k) * 64 + lane]; H = a * H + u; A *= a; }
      TOT[(w * 64 + lane) * 2] = A; TOT[(w * 64 + lane) * 2 + 1] = H; }
    __syncthreads();
    if (!final) {
        if (w == 0) { float A = 1.f, H = 0.f;
#pragma unroll
            for (int ww = 0; ww < 8; ++ww) { const float a = TOT[(ww * 64 + lane) * 2], h = TOT[(ww * 64 + lane) * 2 + 1]; H = a * H + h; A *= a; }
            c.lruA[gc * 256 + hd * 64 + lane] = A; c.lruH[gc * 256 + hd * 64 + lane] = H; }
    } else {
        float h = c.lruC[gc * 256 + hd * 64 + lane];
        for (int ww = 0; ww < w; ++ww) h = TOT[(ww * 64 + lane) * 2] * h + TOT[(ww * 64 + lane) * 2 + 1];
        bf16_t* br1 = c.bufB + (size_t)T * 256;
#pragma unroll 4
        for (int k = 0; k < 16; ++k) { const int tt = 16 * w + k; h = AA[tt * 64 + lane] * h + UU[tt * 64 + lane]; br1[(size_t)(t0 + tt) * 256 + hd * 64 + lane] = f2bf(h); }
    }
    __syncthreads();
}

__device__ __forceinline__ void sc_all(const Ctx& c, int l, int gtid, int gsz) {
    for (int i = gtid; i < T * 32; i += gsz) { const int t = i >> 5, ch = (i & 31) * 8, sq = t % S; float acc[8];
#pragma unroll
        for (int j = 0; j < 8; ++j) acc[j] = c.sc_b[l * 256 + ch + j];
#pragma unroll
        for (int k = 0; k < 3; ++k) if (sq - 2 + k >= 0) { const bf16_t* row = c.zmix + (size_t)(t - 2 + k) * NMIX; const u32x4 cv = *(const u32x4*)(row + C_SCC + ch), xv = *(const u32x4*)(row + C_SCX + ch);
#pragma unroll
            for (int j = 0; j < 8; ++j) acc[j] += c.sc_w[(l * 3 + k) * 256 + ch + j] * (bfel(cv, j) * bfel(xv, j)); }
        const u32x4 bv = *(const u32x4*)(c.zmix + (size_t)t * NMIX + C_SCB + ch);
#pragma unroll
        for (int j = 0; j < 8; ++j) acc[j] *= bfel(bv, j);
        *(u32x4*)(c.bufB + (size_t)t * 256 + ch) = pack8(acc); }
}

__device__ __forceinline__ void m1(const Ctx& c, int l, LAS unsigned char* lds, int G, int bx) {
    int tid = threadIdx.x; asm volatile("" : "+v"(tid));
    for (int it = bx; it < 3 * NCHT * 4; it += G) { const int kind = it / (NCHT * 4), r = it % (NCHT * 4), gc = r >> 2, hh = r & 3;
        if (kind == 0) ret_kv_item(c, gc, hh, lds, tid); else if (kind == 1) lru_item(c, l, gc, hh, false, lds, tid); else sg_item(c, l, gc, hh, lds, tid); }
    sc_all(c, l, bx * 512 + tid, G * 512);
}
__device__ __forceinline__ void m2(const Ctx& c, int l, LAS unsigned char* lds, int G, int bx) {
    int tid = threadIdx.x; asm volatile("" : "+v"(tid));
    for (int it = bx; it < 2 * NCHT * 4; it += G) { const int kind = it / (NCHT * 4), r = it % (NCHT * 4), gc = r >> 2, hh = r & 3;
        if (kind == 0) ret_out_item(c, l, gc, hh, lds, tid); else lru_item(c, l, gc, hh, true, lds, tid); }
}
}

namespace cg = cooperative_groups;
constexpr int LDS_BYTES = 147456;

__global__ void __launch_bounds__(512, 2) mega_fwd(Ctx c) {
    extern __shared__ __attribute__((aligned(16))) unsigned char lds_raw[];
    PG8_LAS unsigned char* lds = (PG8_LAS unsigned char*)lds_raw;
    cg::grid_group grid = cg::this_grid();
    const int gsz = gridDim.x * 512, G = gridDim.x, bx = blockIdx.x;
#define FRESH_GTID int gtid = blockIdx.x * 512 + threadIdx.x; asm volatile("" : "+v"(gtid))

    fast::p0(c, lds, G, bx);
    grid.sync();
    for (int l = 0; l < 2; ++l) {
        {
            pg8::Gemm g{c.bufA, c.w_in_t + (size_t)l * NIN * D, D}; pg8::SchedGrid Sd{T / 256, NIN / 256, G, bx}; pg8::EpiZ E{c.zmix, c.zgate};
            pg8::gemm_phase(lds, g, pg8::build_units(lds, Sd), E);
        }
        grid.sync();
        mix::m1(c, l, lds, G, bx);
        grid.sync();
        { FRESH_GTID; p3_scan(c, gtid, gsz); }
        grid.sync();
        mix::m2(c, l, lds, G, bx);
        grid.sync();
        {
            pg8::Gemm g{c.bufB, c.bp_t + (size_t)l * 4 * D * 256, 256}; pg8::SchedBP Sd{T / 256, D / 256, G, bx}; pg8::EpiBP E{c.zgate, c.part, c.bufA};
            pg8::gemm_phase(lds, g, pg8::build_units(lds, Sd), E);
        }
        grid.sync();
        {
            pg8::Gemm g{c.bufA, c.wout_t + (size_t)l * D * D, D}; pg8::SchedGrid Sd{T / 256, D / 256, G, bx}; pg8::EpiRes E{c.out};
            pg8::gemm_phase(lds, g, pg8::build_units(lds, Sd), E);
        }
        grid.sync();
        fast::p7(c, l, lds, G, bx);
        grid.sync();
        fast::p8(c, l, lds, G, bx);
        grid.sync();
        {
            pg8::Gemm g{c.xg, c.expA, D}; pg8::SchedMoE Sd{c.ctl + CW_CNT + l * 32, 2, G, bx}; pg8::EpiHid E{c.hid};
            pg8::gemm_phase(lds, g, pg8::build_units(lds, Sd), E);
        }
        grid.sync();
        {
            pg8::Gemm g{c.hid, c.expB, 256}; pg8::SchedMoE Sd{c.ctl + CW_CNT + l * 32, 4, G, bx}; pg8::EpiY E{c.xg};
            pg8::gemm_phase(lds, g, pg8::build_units(lds, Sd), E);
        }
        grid.sync();
        fast::p11(c, l, G, bx);
        if (l == 0) grid.sync();
    }
}

extern "C" void kernel_launch(void* const* d_in, const int* in_sizes, int n_in, void* d_out, int out_size, void* d_ws, size_t ws_size, hipStream_t stream) {
    static int grid = 0;
    if (grid == 0) {
        if (n_in != 29 || out_size != T * D || ws_size < WS_END) { fprintf(stderr, "kernel_launch: unexpected shapes (n_in %d out %d ws %zu need %zu)\n", n_in, out_size, ws_size, (size_t)WS_END); grid = -1; return; }
        int dev = 0, cus = 0, per_cu = 0;
        hipGetDevice(&dev); hipDeviceGetAttribute(&cus, hipDeviceAttributeMultiprocessorCount, dev);
        hipFuncSetAttribute((const void*)mega_fwd, hipFuncAttributeMaxDynamicSharedMemorySize, LDS_BYTES);
        hipOccupancyMaxActiveBlocksPerMultiprocessor(&per_cu, (const void*)mega_fwd, 512, LDS_BYTES);
        if (per_cu < 1) { fprintf(stderr, "kernel_launch: occupancy query says %d blocks per CU\n", per_cu); grid = -1; return; }
        grid = cus;
    }
    if (grid < 0) return;
    hipMemsetAsync((char*)d_ws + WS_CTL, 0, CTL_BYTES, stream);
    Ctx c; memset(&c, 0, sizeof(c)); ctx_fill(c, d_in, d_out, d_ws);
    void* args[] = {&c};
    hipError_t e = hipLaunchCooperativeKernel((const void*)mega_fwd, dim3(grid), dim3(512), args, LDS_BYTES, stream);
    if (e != hipSuccess) fprintf(stderr, "cooperative launch failed: %s (grid %d)\n", hipGetErrorString(e), grid);
}
#endif
```
